# Optimizing an MI355X kernel written in HIP

```python
import math
import jax
import jax.numpy as jnp
from jax import lax
import numpy as np

D_MODEL = 1024
BATCH = 16
SEQ = 2048
DEPTH = 2

DIFF_HEADS = 4
DIFF_QK_DIM = 64
DIFF_V_DIM = 128
GLA_HEADS = 4
GLA_DK = 64
GLA_DV = 128
GLA_GATE_RANK = 16
GLA_GATE_NORM = 16.0
HGRN_HEADS = 4
HGRN_EXPAND = 128
HGRN_DV = 128
N_BRANCHES = 3
BRANCH_WIDTH = 512
D_FF = 4 * D_MODEL
CHUNK = 64
Q_BLOCK = 128
ALPHA = (2 * DEPTH) ** 0.25
BETA = (8 * DEPTH) ** -0.25
LN_EPS = 1e-5
MASK_VALUE = -1e30
LB_FLOOR = 1e-30
SPLIT_SIZES = (
    DIFF_HEADS * 2 * DIFF_QK_DIM,
    DIFF_HEADS * 2 * DIFF_QK_DIM,
    DIFF_HEADS * DIFF_V_DIM,
    GLA_HEADS * GLA_DK,
    GLA_HEADS * GLA_DK,
    GLA_HEADS * GLA_DV,
    GLA_GATE_RANK,
    GLA_HEADS * GLA_DV,
    HGRN_HEADS * HGRN_EXPAND,
    HGRN_HEADS * HGRN_EXPAND,
    HGRN_HEADS * HGRN_DV,
    HGRN_HEADS * HGRN_DV,
    N_BRANCHES * D_MODEL,
)
IN_WIDTH = sum(SPLIT_SIZES)

kernel_name = 'hybrid_diffattn_gla_hgrn2_deepnorm'


def layer_norm(x, w, b):
    xf = x.astype(jnp.float32)
    mu = jnp.mean(xf, axis=-1, keepdims=True)
    var = jnp.mean(jnp.square(xf - mu), axis=-1, keepdims=True)
    y = (xf - mu) * lax.rsqrt(var + LN_EPS) * w.astype(jnp.float32) + b.astype(jnp.float32)
    return y.astype(x.dtype)


def rms_norm(x, w):
    xf = x.astype(jnp.float32)
    y = xf * lax.rsqrt(jnp.mean(jnp.square(xf), axis=-1, keepdims=True) + LN_EPS)
    return y * w.astype(jnp.float32)


def split_columns(z):
    points = np.cumsum(np.array(SPLIT_SIZES))[:-1]
    return jnp.split(z, points, axis=-1)


def to_heads(a, n_heads):
    b, t, _ = a.shape
    return a.reshape(b, t, n_heads, -1).transpose(0, 2, 1, 3)


def from_heads(a):
    b, h, t, d = a.shape
    return a.transpose(0, 2, 1, 3).reshape(b, t, h * d)


def diff_attention(q, k, v, lam):
    h = q.shape[1]
    t = q.shape[3]
    d = q.shape[4]
    slopes = jnp.exp2(-8.0 * jnp.arange(1, h + 1, dtype=jnp.float32) / h)
    scale = d ** -0.5
    vf = v.astype(jnp.float32)
    outs = []
    for blk in range(t // Q_BLOCK):
        start = blk * Q_BLOCK
        end = start + Q_BLOCK
        qb = q[:, :, :, start:end].astype(jnp.float32)
        kb = k[:, :, :, :end].astype(jnp.float32)
        s = jnp.einsum('bhmqd,bhmkd->bhmqk', qb, kb) * scale
        dist = (jnp.arange(start, end)[:, None] - jnp.arange(end)[None, :]).astype(jnp.float32)
        s = s - slopes[:, None, None, None] * dist
        s = jnp.where(dist >= 0, s, MASK_VALUE)
        p = jax.nn.softmax(s, axis=-1)
        a = p[:, :, 0] - lam * p[:, :, 1]
        outs.append(jnp.einsum('bhqk,bhkd->bhqd', a, vf[:, :, :end]))
    return jnp.concatenate(outs, axis=2)


def chunked_gated_linear_attention(q, k, v, log_g):
    b, h, t, dk = q.shape
    dv = v.shape[-1]
    nc = t // CHUNK

    def to_chunks(a):
        return a.astype(jnp.float32).reshape(b, h, nc, CHUNK, a.shape[-1]).transpose(2, 0, 1, 3, 4)

    qc, kc, vc, gc = to_chunks(q), to_chunks(k), to_chunks(v), to_chunks(log_g)
    causal = jnp.tril(jnp.ones((CHUNK, CHUNK), dtype=bool))[:, :, None]

    def step(state, inp):
        qi, ki, vi, gi = inp
        cum = jnp.cumsum(gi, axis=-2)
        diff = cum[..., :, None, :] - cum[..., None, :, :]
        decay = jnp.where(causal, jnp.exp(jnp.where(causal, diff, 0.0)), 0.0)
        scores = jnp.einsum('bhid,bhjd,bhijd->bhij', qi, ki, decay)
        o = jnp.einsum('bhij,bhje->bhie', scores, vi)
        o = o + jnp.einsum('bhid,bhde->bhie', qi * jnp.exp(cum), state)
        last = cum[..., -1:, :]
        new_state = jnp.exp(last)[..., 0, :, None] * state + jnp.einsum(
            'bhjd,bhje->bhde', ki * jnp.exp(last - cum), vi)
        return new_state, o

    s0 = jnp.zeros((b, h, dk, dv), dtype=jnp.float32)
    _, o = lax.scan(step, s0, (qc, kc, vc, gc))
    return o.transpose(1, 2, 0, 3, 4).reshape(b, h, t, dv)


def setup_inputs(seed: int = 0) -> dict:
    key = jax.random.key(seed)
    ks = jax.random.split(key, 18)
    n = jax.random.normal
    f32 = jnp.float32
    return {
        'x': n(ks[0], (BATCH, SEQ, D_MODEL), f32),
        'w_in': n(ks[1], (DEPTH, D_MODEL, IN_WIDTH), f32) * D_MODEL ** -0.5,
        'gla_w_gate': n(ks[2], (DEPTH, GLA_GATE_RANK, GLA_HEADS * GLA_DK), f32) * GLA_GATE_RANK ** -0.5,
        'gla_b_gate': 0.01 * n(ks[3], (DEPTH, GLA_HEADS * GLA_DK), f32),
        'diff_lambda': 0.1 * n(ks[4], (DEPTH, 4, DIFF_QK_DIM), f32),
        'diff_norm_w': 1.0 + 0.02 * n(ks[5], (DEPTH, DIFF_V_DIM), f32),
        'gla_norm_w': 1.0 + 0.02 * n(ks[6], (DEPTH, GLA_DV), f32),
        'hgrn_norm_w': 1.0 + 0.02 * n(ks[7], (DEPTH, HGRN_DV), f32),
        'hgrn_lb': n(ks[8], (DEPTH, HGRN_HEADS * HGRN_EXPAND), f32),
        'w_branch': n(ks[9], (DEPTH, N_BRANCHES, BRANCH_WIDTH, D_MODEL), f32) * BRANCH_WIDTH ** -0.5 * BETA,
        'w_out': n(ks[10], (DEPTH, D_MODEL, D_MODEL), f32) * D_MODEL ** -0.5 * BETA,
        'ln1_w': 1.0 + 0.02 * n(ks[11], (DEPTH, D_MODEL), f32),
        'ln1_b': 0.02 * n(ks[12], (DEPTH, D_MODEL), f32),
        'w_up': n(ks[13], (DEPTH, D_MODEL, D_FF), f32) * D_MODEL ** -0.5 * BETA,
        'w_down': n(ks[14], (DEPTH, D_FF, D_MODEL), f32) * D_FF ** -0.5 * BETA,
        'ln2_w': 1.0 + 0.02 * n(ks[15], (DEPTH, D_MODEL), f32),
        'ln2_b': 0.02 * n(ks[16], (DEPTH, D_MODEL), f32),
    }


def reference(x, w_in, gla_w_gate, gla_b_gate, diff_lambda, diff_norm_w, gla_norm_w,
              hgrn_norm_w, hgrn_lb, w_branch, w_out, ln1_w, ln1_b, w_up, w_down, ln2_w, ln2_b):
    dt = x.dtype
    b, t, _ = x.shape
    lb_soft = jax.nn.softmax(hgrn_lb.astype(jnp.float32), axis=0)
    lb_all = jnp.cumsum(lb_soft, axis=0) - lb_soft[0:1]
    for l in range(DEPTH):
        z = x @ w_in[l]
        (qa, ka, va, qg, kg, vg, glr, gout, qh, fh, ih, hout, mg) = split_columns(z)

        qa = qa.reshape(b, t, DIFF_HEADS, 2, DIFF_QK_DIM).transpose(0, 2, 3, 1, 4)
        ka = ka.reshape(b, t, DIFF_HEADS, 2, DIFF_QK_DIM).transpose(0, 2, 3, 1, 4)
        va = to_heads(va, DIFF_HEADS)
        lam_init = 0.8 - 0.6 * math.exp(-0.3 * l)
        lp = diff_lambda[l].astype(jnp.float32)
        lam = jnp.exp(jnp.sum(lp[0] * lp[1])) - jnp.exp(jnp.sum(lp[2] * lp[3])) + lam_init
        oa = diff_attention(qa, ka, va, lam)
        oa = from_heads(rms_norm(oa, diff_norm_w[l]) * (1.0 - lam_init))

        log_g = jax.nn.log_sigmoid((glr @ gla_w_gate[l] + gla_b_gate[l]).astype(jnp.float32)) / GLA_GATE_NORM
        ob = chunked_gated_linear_attention(
            to_heads(qg, GLA_HEADS) * GLA_DK ** -0.5, to_heads(kg, GLA_HEADS),
            to_heads(vg, GLA_HEADS), to_heads(log_g, GLA_HEADS))
        ob = from_heads(rms_norm(ob, gla_norm_w[l]) * jax.nn.silu(to_heads(gout, GLA_HEADS).astype(jnp.float32)))

        lb = lb_all[l]
        log_f = jnp.logaddexp(jnp.log(jnp.maximum(lb, LB_FLOOR)),
                              jnp.log1p(-lb) + jax.nn.log_sigmoid(fh.astype(jnp.float32)))
        k_h = -jnp.expm1(log_f)
        oc = chunked_gated_linear_attention(
            to_heads(qh, HGRN_HEADS), to_heads(k_h, HGRN_HEADS),
            to_heads(ih, HGRN_HEADS), to_heads(log_f, HGRN_HEADS))
        oc = from_heads(rms_norm(oc, hgrn_norm_w[l]) * jax.nn.silu(to_heads(hout, HGRN_HEADS).astype(jnp.float32)))

        branches = jnp.stack([oa, ob, oc], axis=2).astype(dt)
        y = jnp.einsum('btnc,ncd->btnd', branches, w_branch[l])
        gates = jax.nn.sigmoid(mg.reshape(b, t, N_BRANCHES, D_MODEL))
        mix = jnp.einsum('btnd,btnd->btd', gates, y) @ w_out[l]
        x = layer_norm(ALPHA * x + mix, ln1_w[l], ln1_b[l])

        hmid = jnp.square(jax.nn.relu(x @ w_up[l]))
        x = layer_norm(ALPHA * x + hmid @ w_down[l], ln2_w[l], ln2_b[l])
    return x
```

```cpp
#include <hip/hip_runtime.h>
#include <cstdio>
#include <cstdint>

#ifndef MK_N_LAUNCHES
#define MK_N_LAUNCHES 17
#endif
#ifndef MK_PHASE_MASK
#define MK_PHASE_MASK 0x1ff
#endif

namespace pg8 {
#define PG8_LAS __attribute__((address_space(3)))
typedef unsigned short bf16_t;
typedef short bf16x8 __attribute__((ext_vector_type(8)));
typedef float f32x4 __attribute__((ext_vector_type(4)));
typedef unsigned u32x4 __attribute__((ext_vector_type(4)));
constexpr int BM = 256, BK = 64, HALF = 128, HTB = HALF * BK * 2, STAGE_BYTES = 8 * HTB, NXCD = 8, WGM = 8;

__host__ __device__ __forceinline__ int lds_byte(int r, int c) { const int st = (r >> 4) * 2 + (c >> 5), rr = r & 15, cc = c & 31, ob = rr * 64 + cc * 2; return st * 1024 + (ob ^ (((ob >> 9) & 1) << 5)); }
__host__ __device__ __forceinline__ void stage_rc(int b, int& R, int& C) { const int st = b / 1024, sb = b % 1024, swz = sb ^ (((sb >> 9) & 1) << 5); R = (st >> 1) * 16 + swz / 64; C = (st & 1) * 32 + (swz % 64) / 2; }
__host__ __device__ __forceinline__ int perm32(int rho) { const int n = rho >> 4, i = rho & 15; return 8 * (i >> 2) + 4 * n + (i & 3); }

struct Unit { int pm, pn; };
struct Gemm { const bf16_t* A; const bf16_t* Bt; int K, lda, ldb; };

struct StaticOrder {
    int nM, nN, nwg, G, c;
    __host__ __device__ void init(int M, int N, int G_, int c_) { nM = M / BM; nN = N / BM; nwg = nM * nN; G = G_; c = c_; }
    __host__ __device__ bool next(int i, Unit& u) const {
        const long L = (long)i * G + c; if (L >= nwg) return false;
        int wgid = (int)L; { const int q = nwg / NXCD, r = nwg % NXCD, xcd = wgid % NXCD, off = wgid / NXCD; wgid = (xcd < r ? xcd * (q + 1) : r * (q + 1) + (xcd - r) * q) + off; }
        const int nig = WGM * nN, gid = wgid / nig, fm = gid * WGM, gsz = (nM - fm) < WGM ? (nM - fm) : WGM;
        u.pm = fm + ((wgid % nig) % gsz); u.pn = (wgid % nig) / gsz; return true;
    }
    __device__ __forceinline__ void a_ready(const Unit&) const {}
    __device__ __forceinline__ void done(const Unit&) const {}
};

__device__ __forceinline__ unsigned cvt_pk_bf16(float lo, float hi) { unsigned r; asm volatile("v_cvt_pk_bf16_f32 %0, %1, %2" : "=v"(r) : "v"(lo), "v"(hi)); return r; }
__device__ __forceinline__ float bflo(unsigned w) { return __uint_as_float(w << 16); }
__device__ __forceinline__ float bfhi(unsigned w) { return __uint_as_float(w & 0xffff0000u); }

template <int ACT> struct EpiBf16 {
    static constexpr bool PERM = true;
    bf16_t* O; int ldc;
    __device__ __forceinline__ float act(float v) const {
        if (ACT == 1) return 1.0f / (1.0f + __expf(-v));
        if (ACT == 2) { const float r = fmaxf(v, 0.f); return r * r; }
        return v;
    }
    __device__ __forceinline__ void operator()(const f32x4 (&acc)[2][2][4][2], const Unit& u, int wr, int wc, int fr, int fq) const {
        const int row0 = u.pm * BM + wr * 64 + fr, col0 = u.pn * BM + wc * 32 + 8 * fq;
#pragma unroll
        for (int ai = 0; ai < 2; ++ai)
#pragma unroll
            for (int m = 0; m < 4; ++m) { bf16_t* rowp = O + (size_t)(row0 + ai * HALF + m * 16) * ldc + col0;
#pragma unroll
                for (int bj = 0; bj < 2; ++bj) { const f32x4 v0 = acc[ai][bj][m][0], v1 = acc[ai][bj][m][1];
                    u32x4 w; w.x = cvt_pk_bf16(act(v0[0]), act(v0[1])); w.y = cvt_pk_bf16(act(v0[2]), act(v0[3])); w.z = cvt_pk_bf16(act(v1[0]), act(v1[1])); w.w = cvt_pk_bf16(act(v1[2]), act(v1[3]));
                    *(u32x4*)(rowp + bj * HALF) = w; } }
    }
};
struct EpiMerge {
    static constexpr bool PERM = true;
    bf16_t* Mg; const bf16_t* Gt; int ldc; int first;
    __device__ __forceinline__ void operator()(const f32x4 (&acc)[2][2][4][2], const Unit& u, int wr, int wc, int fr, int fq) const {
        const int row0 = u.pm * BM + wr * 64 + fr, col0 = u.pn * BM + wc * 32 + 8 * fq;
#pragma unroll
        for (int ai = 0; ai < 2; ++ai)
#pragma unroll
            for (int m = 0; m < 4; ++m) { const size_t ro = (size_t)(row0 + ai * HALF + m * 16) * ldc + col0;
#pragma unroll
                for (int bj = 0; bj < 2; ++bj) { const f32x4 v0 = acc[ai][bj][m][0], v1 = acc[ai][bj][m][1];
                    const u32x4 g = *(const u32x4*)(Gt + ro + bj * HALF);
                    u32x4 p = (u32x4){0u, 0u, 0u, 0u}; if (!first) p = *(const u32x4*)(Mg + ro + bj * HALF);
                    u32x4 w;
                    w.x = cvt_pk_bf16(bflo(p.x) + bflo(g.x) * v0[0], bfhi(p.x) + bfhi(g.x) * v0[1]);
                    w.y = cvt_pk_bf16(bflo(p.y) + bflo(g.y) * v0[2], bfhi(p.y) + bfhi(g.y) * v0[3]);
                    w.z = cvt_pk_bf16(bflo(p.z) + bflo(g.z) * v1[0], bfhi(p.z) + bfhi(g.z) * v1[1]);
                    w.w = cvt_pk_bf16(bflo(p.w) + bflo(g.w) * v1[2], bfhi(p.w) + bfhi(g.w) * v1[3]);
                    *(u32x4*)(Mg + ro + bj * HALF) = w; } }
    }
};
struct EpiResF32 {
    static constexpr bool PERM = false;
    const float* base; float* out; int ldc; float alpha;
    __device__ __forceinline__ void operator()(const f32x4 (&acc)[2][2][4][2], const Unit& u, int wr, int wc, int fr, int fq) const {
        const int row0 = u.pm * BM + wr * 64 + fr, col0 = u.pn * BM + wc * 32 + 4 * fq;
#pragma unroll
        for (int ai = 0; ai < 2; ++ai)
#pragma unroll
            for (int m = 0; m < 4; ++m) { const size_t ro = (size_t)(row0 + ai * HALF + m * 16) * ldc + col0;
#pragma unroll
                for (int bj = 0; bj < 2; ++bj)
#pragma unroll
                    for (int n = 0; n < 2; ++n) { const f32x4 bs = *(const f32x4*)(base + ro + bj * HALF + n * 16);
                        *(f32x4*)(out + ro + bj * HALF + n * 16) = bs * alpha + acc[ai][bj][m][n]; } }
    }
};

template <class Epi, class Sched, bool ALIGN_EPI = false>
__device__ __forceinline__ void gemm_phase(PG8_LAS unsigned char* lds, const Gemm g, const Sched& S, const Epi& E) {
    int tid_ = threadIdx.x; asm volatile("" : "+v"(tid_));
    const int tid = tid_, wid = __builtin_amdgcn_readfirstlane(tid >> 6), lane = tid & 63, wr = wid >> 2, wc = wid & 3, fr = lane & 15, fq = lane >> 4;
    const int K = g.K, nt = K / BK;
    unsigned voffA[2], voffB[2];
#pragma unroll
    for (int i = 0; i < 2; ++i) { int R, C; stage_rc(tid * 16 + i * 8192, R, C); const int Rb = Epi::PERM ? ((R & ~31) + perm32(R & 31)) : R;
        voffA[i] = (unsigned)(R * g.lda + C) * 2u; voffB[i] = (unsigned)(Rb * g.ldb + C) * 2u; }
    const size_t kstep = (size_t)(BK * 2);
    const size_t hstepA = (size_t)HALF * g.lda * 2, hstepB = (size_t)HALF * g.ldb * 2;
    const size_t tstepA = 2 * hstepA, tstepB = 2 * hstepB;
    const unsigned ldsw = (unsigned)wid * 1024u;
    const int aoff = lds_byte(wr * 64 + fr, fq * 8), boff = lds_byte(wc * 32 + fr, fq * 8);
#define PG8_SA(b, h) (((b) * 2 + (h)) * HTB)
#define PG8_SB(b, h) ((4 + (b) * 2 + (h)) * HTB)
#define PG8_STAGE(bufoff, gbase, voff) do { _Pragma("unroll") for (int _i = 0; _i < 2; ++_i) \
        __builtin_amdgcn_global_load_lds((const unsigned*)((const char*)(gbase) + (voff)[_i]), (PG8_LAS unsigned*)(lds + (bufoff) + ldsw + _i * 8192), 16, 0, 0); } while (0)
#define PG8_LDA(dst, b, h) do { _Pragma("unroll") for (int m = 0; m < 4; ++m) _Pragma("unroll") for (int k = 0; k < 2; ++k) dst[m][k] = *(const PG8_LAS bf16x8*)(lds + PG8_SA(b, h) + aoff + m * 2048 + k * 1024); } while (0)
#define PG8_LDB(dst, b, h) do { _Pragma("unroll") for (int n = 0; n < 2; ++n) _Pragma("unroll") for (int k = 0; k < 2; ++k) dst[n][k] = *(const PG8_LAS bf16x8*)(lds + PG8_SB(b, h) + boff + n * 2048 + k * 1024); } while (0)
#define PG8_MMA(ai, bj, At, Bt) do { __builtin_amdgcn_s_setprio(1); _Pragma("unroll") for (int m = 0; m < 4; ++m) _Pragma("unroll") for (int n = 0; n < 2; ++n) _Pragma("unroll") for (int k = 0; k < 2; ++k) \
        acc[ai][bj][m][n] = __builtin_amdgcn_mfma_f32_16x16x32_bf16(Bt[n][k], At[m][k], acc[ai][bj][m][n], 0, 0, 0); __builtin_amdgcn_s_setprio(0); } while (0)
#define PG8_WAIT_V(n) asm volatile("s_waitcnt vmcnt(" #n ")" ::: "memory")
#define PG8_WAIT_L(n) asm volatile("s_waitcnt lgkmcnt(" #n ")" ::: "memory")
#define PG8_BAR __builtin_amdgcn_s_barrier()
#define PG8_SCHED __builtin_amdgcn_sched_barrier(0)
    Unit cur, nxt; int ui = 0;
    if (!S.next(0, cur)) return;
    f32x4 acc[2][2][4][2];
#pragma unroll
    for (int a = 0; a < 2; ++a)
#pragma unroll
        for (int b = 0; b < 2; ++b)
#pragma unroll
            for (int m = 0; m < 4; ++m)
#pragma unroll
                for (int n = 0; n < 2; ++n) acc[a][b][m][n] = (f32x4){0.f, 0.f, 0.f, 0.f};
    bf16x8 At[4][2], B0[2][2], B1[2][2];
    const char* cA = (const char*)g.A + (size_t)cur.pm * tstepA; const char* cB = (const char*)g.Bt + (size_t)cur.pn * tstepB;
    S.a_ready(cur);
    PG8_STAGE(PG8_SB(0, 0), cB, voffB); PG8_STAGE(PG8_SB(0, 1), cB + hstepB, voffB); PG8_STAGE(PG8_SA(0, 0), cA, voffA); PG8_STAGE(PG8_SA(0, 1), cA + hstepA, voffA);
    if (wr == 1) PG8_BAR;
    PG8_WAIT_V(2); PG8_BAR;
    PG8_STAGE(PG8_SB(1, 0), cB + kstep, voffB); PG8_STAGE(PG8_SA(1, 0), cA + kstep, voffA); PG8_STAGE(PG8_SB(1, 1), cB + hstepB + kstep, voffB);
    PG8_WAIT_V(6); PG8_BAR;
    for (;;) {
        const bool has_next = S.next(ui + 1, nxt);
        const char* nA = has_next ? (const char*)g.A + (size_t)nxt.pm * tstepA : cA; const char* nB = has_next ? (const char*)g.Bt + (size_t)nxt.pn * tstepB : cB;
        for (int t = 0; t < nt; t += 2) {
            const bool last = (t == nt - 2);
            const char* a1 = cA + (size_t)(t + 1) * kstep;
            const char* a2 = last ? nA : cA + (size_t)(t + 2) * kstep; const char* b2 = last ? nB : cB + (size_t)(t + 2) * kstep;
            const char* a3 = a2 + kstep; const char* b3 = b2 + kstep;
            if (last && has_next) S.a_ready(nxt);
            PG8_LDB(B0, 0, 0); PG8_LDB(B1, 0, 1); PG8_SCHED; PG8_LDA(At, 0, 0); PG8_STAGE(PG8_SA(1, 1), a1 + hstepA, voffA);
            PG8_WAIT_V(8); PG8_WAIT_L(0); PG8_BAR; PG8_MMA(0, 0, At, B0); PG8_MMA(0, 1, At, B1); PG8_BAR; PG8_SCHED;
            PG8_LDA(At, 0, 1); PG8_STAGE(PG8_SB(0, 0), b2, voffB); PG8_STAGE(PG8_SB(0, 1), b2 + hstepB, voffB); PG8_STAGE(PG8_SA(0, 0), a2, voffA);
            PG8_WAIT_V(8); PG8_WAIT_L(0); PG8_BAR; PG8_MMA(1, 0, At, B0); PG8_MMA(1, 1, At, B1); PG8_BAR; PG8_SCHED;
            PG8_LDB(B0, 1, 0); PG8_LDB(B1, 1, 1); PG8_SCHED; PG8_LDA(At, 1, 0); PG8_STAGE(PG8_SA(0, 1), a2 + hstepA, voffA);
            PG8_WAIT_V(8); PG8_WAIT_L(0); PG8_BAR; PG8_MMA(0, 0, At, B0); PG8_MMA(0, 1, At, B1); PG8_BAR; PG8_SCHED;
            PG8_LDA(At, 1, 1); PG8_STAGE(PG8_SB(1, 0), b3, voffB); PG8_STAGE(PG8_SB(1, 1), b3 + hstepB, voffB); PG8_STAGE(PG8_SA(1, 0), a3, voffA);
            PG8_WAIT_V(8); PG8_WAIT_L(0); PG8_BAR; PG8_MMA(1, 0, At, B0); PG8_MMA(1, 1, At, B1); PG8_BAR; PG8_SCHED;
        }
        if constexpr (ALIGN_EPI) { if (wr == 0) PG8_BAR; }
        E(acc, cur, wr, wc, fr, fq); S.done(cur);
        if (!has_next) break;
#pragma unroll
        for (int a = 0; a < 2; ++a)
#pragma unroll
            for (int b = 0; b < 2; ++b)
#pragma unroll
                for (int m = 0; m < 4; ++m)
#pragma unroll
                    for (int n = 0; n < 2; ++n) acc[a][b][m][n] = (f32x4){0.f, 0.f, 0.f, 0.f};
        cur = nxt; cA = nA; cB = nB; ++ui;
        if constexpr (ALIGN_EPI) { if (wr == 1) PG8_BAR; }
    }
    PG8_WAIT_V(0);
    if constexpr (!ALIGN_EPI) { if (wr == 0) PG8_BAR; }
    PG8_BAR;
#undef PG8_SA
#undef PG8_SB
#undef PG8_STAGE
#undef PG8_LDA
#undef PG8_LDB
#undef PG8_MMA
#undef PG8_WAIT_V
#undef PG8_WAIT_L
#undef PG8_BAR
#undef PG8_SCHED
}
}

constexpr int NWAVES = 8;
constexpr int BATCH = 16, T = 2048, D = 1024, M = BATCH * T, FF = 4096, DEPTH = 2;
constexpr int IN_WIDTH = 8208;
constexpr int ZW = 5376;
constexpr int ZC_QA = 0, ZC_KA = 512, ZC_VA = 1024, ZC_QG = 1536, ZC_KG = 1792, ZC_VG = 2048, ZC_GO = 2560, ZC_QH = 3072, ZC_FH = 3584, ZC_IH = 4096, ZC_HO = 4608, ZC_GLR = 5120;
constexpr int ZC_MRG = 512;
constexpr int ZC_GATE = 3072;
constexpr int NWIN = ZW + 3 * D;
constexpr float LN_EPS = 1e-5f;
constexpr float ALPHA = 1.41421356237309515f;
constexpr int NPHASE = 1 + 8 * DEPTH;

constexpr size_t MiB = 1u << 20;
constexpr size_t WS_CTL = 0, CTL_ZERO_BYTES = 1 * MiB;
constexpr size_t WS_WIN = 1 * MiB;
constexpr size_t WS_WB = 34 * MiB;
constexpr size_t WS_WOUT = 40 * MiB;
constexpr size_t WS_WUP = 44 * MiB;
constexpr size_t WS_WDN = 60 * MiB;
constexpr size_t WS_XB = 76 * MiB;
constexpr size_t WS_Z = 140 * MiB;
constexpr size_t WS_END = 476 * MiB;
static_assert(WS_WIN + (size_t)DEPTH * NWIN * D * 2 <= WS_WB && WS_Z + (size_t)M * ZW * 2 <= WS_END, "d_ws map");
constexpr int CW_BAR = 4096;
constexpr int CW_QUEUE = 16384;

constexpr int RING_BYTES = 147456;
constexpr int LDSCTL_OFF = RING_BYTES, MISC_OFF = LDSCTL_OFF + 320;
constexpr int LDS_BYTES = RING_BYTES + 1024;

#define GAS __attribute__((address_space(1)))
#define LAS __attribute__((address_space(3)))
typedef unsigned short bf16;
typedef unsigned v4u __attribute__((ext_vector_type(4)));
typedef unsigned v2u __attribute__((ext_vector_type(2)));
typedef float f32x4 __attribute__((ext_vector_type(4)));
typedef GAS unsigned gu32;
#define RLX_AGENT __ATOMIC_RELAXED, __HIP_MEMORY_SCOPE_AGENT
#define LDS_WAIT() asm volatile("s_waitcnt lgkmcnt(0)" ::: "memory")
#define VM_WAIT() asm volatile("s_waitcnt vmcnt(0)" ::: "memory")
__device__ __forceinline__ unsigned f2bf(float f) { unsigned u = __builtin_bit_cast(unsigned, f); return (u + 0x7fffu + ((u >> 16) & 1u)) >> 16; }
__device__ __forceinline__ unsigned pk2(float lo, float hi) { return f2bf(lo) | (f2bf(hi) << 16); }
__device__ __forceinline__ float bf2f(unsigned short b) { return __uint_as_float((unsigned)b << 16); }
__device__ __forceinline__ float wave_sum(float v) {
#pragma unroll
    for (int o = 1; o < 64; o <<= 1) v += __shfl_xor(v, o);
    return v;
}
__device__ __forceinline__ float wave_max(float v) {
#pragma unroll
    for (int o = 1; o < 64; o <<= 1) v = fmaxf(v, __shfl_xor(v, o));
    return v;
}
__device__ __forceinline__ float logsigmoidf(float x) { return fminf(x, 0.f) - log1pf(expf(-fabsf(x))); }

#define XB_TMO      128
#define XB_XCNT(j)  (256  + 64 * (j))
#define XB_XSUB(j)  (1280 + 64 * (j))
#define XB_XGEN(j)  (2304 + 64 * (j))
#define XB_TOP      3328
#define XB_TOPGEN   3392
#define XCD_BAR_WORDS 3456
#define XB_SPIN_CAP (1u << 18)

__device__ __forceinline__ unsigned xb_ld(unsigned* p)              { return __hip_atomic_load(p, __ATOMIC_RELAXED, __HIP_MEMORY_SCOPE_AGENT); }
__device__ __forceinline__ unsigned xb_add(unsigned* p, unsigned v) { return __hip_atomic_fetch_add(p, v, __ATOMIC_RELAXED, __HIP_MEMORY_SCOPE_AGENT); }
__device__ __forceinline__ unsigned xb_xcc_id() { return (unsigned)__builtin_amdgcn_s_getreg((3 << 11) | 20) & 0xFu; }
#define XB_SPIN(cond, bar) do { unsigned _sp = 0; while (cond) { __builtin_amdgcn_s_sleep(1); \
    if ((++_sp & 255u) == 0u) { if (xb_ld(&(bar)[XB_TMO])) break; if (_sp > XB_SPIN_CAP) { atomicAdd(&(bar)[XB_TMO], 1u); break; } } } } while (0)

struct XcdBarrier {
    unsigned* bar; unsigned x;
    volatile LAS unsigned* st;
};
__device__ __forceinline__ XcdBarrier xcd_barrier_post(unsigned* bar, volatile LAS unsigned* st) {
    XcdBarrier b; b.bar = bar; b.x = xb_xcc_id(); b.st = st;
    if (threadIdx.x == 0) (void)xb_add(&bar[XB_XCNT(b.x)], 1u);
    return b;
}
__device__ __forceinline__ void xcd_barrier_complete(unsigned* bar, unsigned x, unsigned& nloc, unsigned& nx) {
    const unsigned G = gridDim.x * gridDim.y * gridDim.z;
    unsigned sum, cnt, mine, sp = 0u;
    for (;;) {
        sum = 0u; cnt = 0u; mine = 0u;
#pragma unroll
        for (unsigned j = 0; j < 16; ++j) { const unsigned c = xb_ld(&bar[XB_XCNT(j)]); sum += c; cnt += (c > 0u) ? 1u : 0u; mine = (j == x) ? c : mine; }
        if (sum == G) break;
        __builtin_amdgcn_s_sleep(1);
        if ((++sp & 255u) == 0u) { if (xb_ld(&bar[XB_TMO])) break; if (sp > XB_SPIN_CAP) { atomicAdd(&bar[XB_TMO], 1u); break; } }
    }
    nloc = mine > 0u ? mine : 1u; nx = cnt > 0u ? cnt : 1u;
}
__device__ __forceinline__ void xcd_barrier(const XcdBarrier& b) {
    asm volatile("s_waitcnt vmcnt(0)" ::: "memory");
    __syncthreads();
    if (threadIdx.x == 0) {
        unsigned* bar = b.bar;
        __builtin_amdgcn_s_waitcnt(0);
        unsigned nloc = b.st[0], nx = b.st[1];
        if (nloc == 0u) { xcd_barrier_complete(bar, b.x, nloc, nx); b.st[0] = nloc; b.st[1] = nx; }
        const unsigned old = xb_add(&bar[XB_XSUB(b.x)], 1u);
        const unsigned gen = old / nloc;
        if (old + 1u == (gen + 1u) * nloc) {
            __builtin_amdgcn_fence(__ATOMIC_RELEASE, "agent");
            asm volatile("s_waitcnt vmcnt(0)" ::: "memory");
            const unsigned og = xb_add(&bar[XB_TOP], 1u);
            const unsigned tg = og / nx;
            if (og + 1u == (tg + 1u) * nx) xb_add(&bar[XB_TOPGEN], 1u);
            else XB_SPIN(xb_ld(&bar[XB_TOPGEN]) == tg, bar);
            __builtin_amdgcn_fence(__ATOMIC_ACQUIRE, "agent");
            xb_add(&bar[XB_XGEN(b.x)], 1u);
            asm volatile("s_waitcnt vmcnt(0)" ::: "memory");
        } else {
            XB_SPIN(xb_ld(&bar[XB_XGEN(b.x)]) == gen, bar);
            __builtin_amdgcn_fence(__ATOMIC_ACQUIRE, "agent");
            asm volatile("s_waitcnt vmcnt(0)" ::: "memory");
        }
    }
    __syncthreads();
}

struct Frame {
    LAS unsigned char* lds;
    volatile LAS unsigned* MISC;
    gu32* ctl;
    int vcu, G;
};
#define PHASE_IDS() int tid_o_ = threadIdx.x; asm volatile("" : "+v"(tid_o_)); const int tid = tid_o_, lane = tid & 63, wave = __builtin_amdgcn_readfirstlane(tid >> 6); (void)tid; (void)lane; (void)wave

__device__ __forceinline__ int win_src_col(int j) {
    if (j < 2560) return j;
    if (j < 5120) return j + 16;
    if (j < 5136) return j - 5120 + 2560;
    if (j < ZW) return -1;
    return j - ZW + 5136;
}
template <bool MAPWIN>
__device__ __forceinline__ void p0_transpose_item(const float* W, int K, int Nsrc, int Ndst, bf16* WT, LAS float* scr, int item, int lane) {
    const int nblk = Ndst / 32, kb = item / nblk, nb = item % nblk, k0 = 64 * kb, n0 = 32 * nb;
    const int nd = n0 + (lane & 31); const int sc = MAPWIN ? win_src_col(nd) : nd;
#pragma unroll 8
    for (int i = 0; i < 32; ++i) { const int kk = 2 * i + (lane >> 5); scr[kk * 33 + (lane & 31)] = (sc >= 0) ? W[(size_t)(k0 + kk) * Nsrc + sc] : 0.f; }
    LDS_WAIT(); asm volatile("" ::: "memory");
    const int c = lane & 7;
#pragma unroll
    for (int j = 0; j < 4; ++j) { const int n = (lane >> 3) + 8 * j; const LAS float* s = scr + (8 * c) * 33 + n;
        v4u o; o.x = pk2(s[0 * 33], s[1 * 33]); o.y = pk2(s[2 * 33], s[3 * 33]); o.z = pk2(s[4 * 33], s[5 * 33]); o.w = pk2(s[6 * 33], s[7 * 33]);
        *(GAS v4u*)(WT + (size_t)(n0 + n) * K + k0 + 8 * c) = o; }
    LDS_WAIT(); asm volatile("" ::: "memory");
}

struct Args { const float* in[17]; float* out; unsigned char* ws; int ph_lo, ph_hi; };

__device__ __forceinline__ void p0_prologue(Frame& F, const Args& a) {
    PHASE_IDS();
    LAS float* scr = (LAS float*)(F.lds + wave * 16384);
    const int gw = F.vcu * NWAVES + wave, NGW = F.G * NWAVES;
    constexpr int I_IN = (D / 64) * (NWIN / 32), I_BR = (512 / 64) * (D / 32), I_OUT = (D / 64) * (D / 32), I_UP = (D / 64) * (FF / 32), I_DN = (FF / 64) * (D / 32);
    constexpr int PER_LAYER = I_IN + 3 * I_BR + I_OUT + I_UP + I_DN;
    for (int it = gw; it < DEPTH * PER_LAYER; it += NGW) {
        const int l = it / PER_LAYER; int r = it % PER_LAYER;
        if (r < I_IN) { p0_transpose_item<true>(a.in[1] + (size_t)l * D * IN_WIDTH, D, IN_WIDTH, NWIN, (bf16*)(a.ws + WS_WIN) + (size_t)l * NWIN * D, scr, r, lane); continue; } r -= I_IN;
        if (r < 3 * I_BR) { const int n = r / I_BR; p0_transpose_item<false>(a.in[9] + (size_t)(l * 3 + n) * 512 * D, 512, D, D, (bf16*)(a.ws + WS_WB) + (size_t)(l * 3 + n) * D * 512, scr, r % I_BR, lane); continue; } r -= 3 * I_BR;
        if (r < I_OUT) { p0_transpose_item<false>(a.in[10] + (size_t)l * D * D, D, D, D, (bf16*)(a.ws + WS_WOUT) + (size_t)l * D * D, scr, r, lane); continue; } r -= I_OUT;
        if (r < I_UP) { p0_transpose_item<false>(a.in[13] + (size_t)l * D * FF, D, FF, FF, (bf16*)(a.ws + WS_WUP) + (size_t)l * FF * D, scr, r, lane); continue; } r -= I_UP;
        p0_transpose_item<false>(a.in[14] + (size_t)l * FF * D, FF, D, D, (bf16*)(a.ws + WS_WDN) + (size_t)l * D * FF, scr, r, lane);
    }
    const float* x = a.in[0]; bf16* XB = (bf16*)(a.ws + WS_XB);
    for (int m = gw; m < M; m += NGW) {
        const GAS f32x4* xr = (const GAS f32x4*)(x + (size_t)m * D) + lane;
        GAS unsigned long long* o8 = (GAS unsigned long long*)(XB + (size_t)m * D) + lane;
#pragma unroll
        for (int j = 0; j < 4; ++j) { const f32x4 v = xr[64 * j]; o8[64 * j] = (unsigned long long)pk2(v.x, v.y) | ((unsigned long long)pk2(v.z, v.w) << 32); }
    }
}

__device__ __forceinline__ void ln_phase(Frame& F, float* R, bf16* XB, const float* w, const float* b) {
    PHASE_IDS();
    const int gw = F.vcu * NWAVES + wave, NGW = F.G * NWAVES;
    f32x4 wv[4], bv[4];
#pragma unroll
    for (int j = 0; j < 4; ++j) { wv[j] = ((const f32x4*)w)[lane + 64 * j]; bv[j] = ((const f32x4*)b)[lane + 64 * j]; }
    for (int m = gw; m < M; m += NGW) {
        GAS f32x4* xr = (GAS f32x4*)(R + (size_t)m * D) + lane;
        f32x4 v[4]; float s = 0.f;
#pragma unroll
        for (int j = 0; j < 4; ++j) { v[j] = xr[64 * j]; s += (v[j].x + v[j].y) + (v[j].z + v[j].w); }
        const float mean = wave_sum(s) * (1.f / D); float s2 = 0.f;
#pragma unroll
        for (int j = 0; j < 4; ++j) { v[j] = v[j] - mean; s2 += (v[j].x * v[j].x + v[j].y * v[j].y) + (v[j].z * v[j].z + v[j].w * v[j].w); }
        const float rstd = 1.f / sqrtf(wave_sum(s2) * (1.f / D) + LN_EPS);
        GAS unsigned long long* o8 = (GAS unsigned long long*)(XB + (size_t)m * D) + lane;
#pragma unroll
        for (int j = 0; j < 4; ++j) { const f32x4 y = v[j] * rstd * wv[j] + bv[j]; xr[64 * j] = y;
            o8[64 * j] = (unsigned long long)pk2(y.x, y.y) | ((unsigned long long)pk2(y.z, y.w) << 32); }
    }
}

__device__ __forceinline__ void attn_naive_item(Frame& F, bf16* Z, int b, int h, int rb, float lam, float post, const float* normw) {
    PHASE_IDS();
    LAS float* sb1 = (LAS float*)(F.lds + wave * 16384);
    LAS float* sb2 = sb1 + 2048;
    LAS float* qb = (LAS float*)(F.lds + 131072 + wave * 512);
    const float slope = exp2f(-2.0f * (float)(h + 1));
    const bf16* zb = Z + (size_t)b * T * ZW;
    for (int rr = 0; rr < 8; ++rr) {
        const int i = rb * 64 + wave * 8 + rr;
        const bf16* qrow = zb + (size_t)i * ZW + ZC_QA + h * 128;
        qb[lane] = bf2f(qrow[lane]) * 0.125f; qb[64 + lane] = bf2f(qrow[64 + lane]) * 0.125f;
        LDS_WAIT();
        float m1 = -1e30f, m2 = -1e30f;
        for (int j0 = 0; j0 <= i; j0 += 64) {
            const int j = j0 + lane;
            if (j <= i) {
                const bf16* krow = zb + (size_t)j * ZW + ZC_KA + h * 128;
                float d1 = 0.f, d2 = 0.f;
#pragma unroll
                for (int c = 0; c < 8; ++c) {
                    const v4u k1 = *(const v4u*)(krow + c * 8), k2 = *(const v4u*)(krow + 64 + c * 8);
                    const f32x4 qa = *(const LAS f32x4*)(qb + c * 8), qc = *(const LAS f32x4*)(qb + c * 8 + 4);
                    const f32x4 qd = *(const LAS f32x4*)(qb + 64 + c * 8), qe = *(const LAS f32x4*)(qb + 64 + c * 8 + 4);
                    d1 += qa.x * pg8::bflo(k1.x) + qa.y * pg8::bfhi(k1.x) + qa.z * pg8::bflo(k1.y) + qa.w * pg8::bfhi(k1.y)
                        + qc.x * pg8::bflo(k1.z) + qc.y * pg8::bfhi(k1.z) + qc.z * pg8::bflo(k1.w) + qc.w * pg8::bfhi(k1.w);
                    d2 += qd.x * pg8::bflo(k2.x) + qd.y * pg8::bfhi(k2.x) + qd.z * pg8::bflo(k2.y) + qd.w * pg8::bfhi(k2.y)
                        + qe.x * pg8::bflo(k2.z) + qe.y * pg8::bfhi(k2.z) + qe.z * pg8::bflo(k2.w) + qe.w * pg8::bfhi(k2.w);
                }
                const float bias = slope * (float)(i - j);
                const float s1 = d1 - bias, s2 = d2 - bias;
                sb1[j] = s1; sb2[j] = s2; m1 = fmaxf(m1, s1); m2 = fmaxf(m2, s2);
            }
        }
        m1 = wave_max(m1); m2 = wave_max(m2);
        float l1 = 0.f, l2 = 0.f;
        for (int j0 = 0; j0 <= i; j0 += 64) { const int j = j0 + lane;
            if (j <= i) { const float e1 = expf(sb1[j] - m1), e2 = expf(sb2[j] - m2); sb1[j] = e1; sb2[j] = e2; l1 += e1; l2 += e2; } }
        l1 = wave_sum(l1); l2 = wave_sum(l2);
        const float r1 = 1.0f / l1, r2 = lam / l2;
        for (int j0 = 0; j0 <= i; j0 += 64) { const int j = j0 + lane; if (j <= i) sb1[j] = sb1[j] * r1 - sb2[j] * r2; }
        LDS_WAIT();
        float a0 = 0.f, a1 = 0.f;
        const bf16* vcol = zb + ZC_VA + h * 128 + 2 * lane;
#pragma unroll 4
        for (int j = 0; j <= i; ++j) { const float a = sb1[j]; const unsigned vv = *(const unsigned*)(vcol + (size_t)j * ZW); a0 += a * pg8::bflo(vv); a1 += a * pg8::bfhi(vv); }
        const float ss = wave_sum(a0 * a0 + a1 * a1) * (1.0f / 128.0f);
        const float r = post / sqrtf(ss + LN_EPS);
        const float o0 = a0 * r * normw[2 * lane], o1 = a1 * r * normw[2 * lane + 1];
        *(GAS unsigned*)((bf16*)zb + (size_t)i * ZW + ZC_QA + h * 128 + 2 * lane) = pk2(o0, o1);
        LDS_WAIT();
    }
}

template <int MIXER>
__device__ __forceinline__ void chain_naive_unit(Frame& F, bf16* Z, int b, int h, int l, const Args& a) {
    constexpr int DK = MIXER == 0 ? 64 : 128, DKS = DK / 4, CH = 32;
    constexpr int ZQ = MIXER == 0 ? ZC_QG : ZC_QH, ZK = MIXER == 0 ? ZC_KG : ZC_FH, ZV = MIXER == 0 ? ZC_VG : ZC_IH, ZG = MIXER == 0 ? ZC_GO : ZC_HO;
    LAS float* ge = (LAS float*)F.lds;
    LAS float* qs = ge + CH * DK;
    LAS float* ks = qs + CH * DK;
    LAS float* vs = (LAS float*)(F.lds + 49152);
    LAS float* op = (LAS float*)(F.lds + 65536);
    PHASE_IDS();
    const int col = tid & 127, sl = tid >> 7;
    bf16* zb = Z + (size_t)b * T * ZW;
    const float* normw = (MIXER == 0 ? a.in[6] : a.in[7]) + l * 128;
    const float* Wg = a.in[2] + (size_t)l * 16 * 256; const float* bg = a.in[3] + l * 256;
    const float* lbp = a.in[8];
    float S[DKS];
#pragma unroll
    for (int d = 0; d < DKS; ++d) S[d] = 0.f;
    for (int c0 = 0; c0 < T; c0 += CH) {
        for (int idx = tid; idx < CH * DK; idx += 512) {
            const int t = idx / DK, d = idx % DK; const bf16* zr = zb + (size_t)(c0 + t) * ZW;
            float lg, kv, qv;
            if (MIXER == 0) {
                float pre = bg[h * 64 + d];
#pragma unroll
                for (int r = 0; r < 16; ++r) pre += bf2f(zr[ZC_GLR + r]) * Wg[r * 256 + h * 64 + d];
                lg = logsigmoidf(pre) * (1.0f / 16.0f); kv = bf2f(zr[ZK + h * DK + d]); qv = bf2f(zr[ZQ + h * DK + d]) * 0.125f;
            } else {
                const int c = h * 128 + d; const float x0 = lbp[c], x1 = lbp[512 + c], mx = fmaxf(x0, x1), e0 = expf(x0 - mx), e1 = expf(x1 - mx);
                const float lb = (l == 0) ? 0.f : e1 / (e0 + e1);
                const float aa = logf(fmaxf(lb, 1e-30f)), bb = log1pf(-lb) + logsigmoidf(bf2f(zr[ZK + c]));
                lg = fmaxf(aa, bb) + log1pf(expf(-fabsf(aa - bb))); kv = -expm1f(lg); qv = bf2f(zr[ZQ + c]);
            }
            ge[idx] = expf(lg); ks[idx] = kv; qs[idx] = qv;
        }
        for (int idx = tid; idx < CH * 128; idx += 512) { const int t = idx >> 7, c = idx & 127; vs[idx] = bf2f(zb[(size_t)(c0 + t) * ZW + ZV + h * 128 + c]); }
        __syncthreads();
        for (int t = 0; t < CH; ++t) {
            const float v = vs[t * 128 + col]; float o = 0.f;
#pragma unroll
            for (int d4 = 0; d4 < DKS; d4 += 4) {
                const f32x4 g4 = *(const LAS f32x4*)(ge + t * DK + sl * DKS + d4), k4 = *(const LAS f32x4*)(ks + t * DK + sl * DKS + d4), q4 = *(const LAS f32x4*)(qs + t * DK + sl * DKS + d4);
                S[d4 + 0] = g4.x * S[d4 + 0] + k4.x * v; o += q4.x * S[d4 + 0];
                S[d4 + 1] = g4.y * S[d4 + 1] + k4.y * v; o += q4.y * S[d4 + 1];
                S[d4 + 2] = g4.z * S[d4 + 2] + k4.z * v; o += q4.z * S[d4 + 2];
                S[d4 + 3] = g4.w * S[d4 + 3] + k4.w * v; o += q4.w * S[d4 + 3];
            }
            op[(sl * CH + t) * 128 + col] = o;
        }
        __syncthreads();
#pragma unroll
        for (int tt = 0; tt < 4; ++tt) {
            const int t = wave * 4 + tt, c = 2 * lane;
            float o0 = 0.f, o1 = 0.f;
#pragma unroll
            for (int s = 0; s < 4; ++s) { o0 += op[(s * CH + t) * 128 + c]; o1 += op[(s * CH + t) * 128 + c + 1]; }
            const float ss = wave_sum(o0 * o0 + o1 * o1) * (1.0f / 128.0f), r = 1.0f / sqrtf(ss + LN_EPS);
            bf16* zr = zb + (size_t)(c0 + t) * ZW;
            const unsigned gw2 = *(const unsigned*)(zr + ZG + h * 128 + c);
            const float g0 = pg8::bflo(gw2), g1 = pg8::bfhi(gw2);
            const float y0 = o0 * r * normw[c] * (g0 / (1.0f + expf(-g0))), y1 = o1 * r * normw[c + 1] * (g1 / (1.0f + expf(-g1)));
            *(GAS unsigned*)(zr + ZV + h * 128 + c) = pk2(y0, y1);
        }
        __syncthreads();
    }
}

__global__ void __launch_bounds__(NWAVES * 64, 2) skel_fwd(Args args) {
    extern __shared__ __attribute__((aligned(16))) unsigned char lds[];
    Frame F;
    F.lds = (LAS unsigned char*)lds;
    F.MISC = (volatile LAS unsigned*)(F.lds + MISC_OFF);
    F.G = gridDim.x; { const int bx = blockIdx.x; F.vcu = (F.G % 8 == 0) ? (bx % 8) * (F.G / 8) + bx / 8 : bx; }
    unsigned char* ws = args.ws;
    F.ctl = (gu32*)(ws + WS_CTL);
    for (int u = threadIdx.x; u < (LDS_BYTES - LDSCTL_OFF) / 4; u += NWAVES * 64) ((LAS unsigned*)(F.lds + LDSCTL_OFF))[u] = 0u;
    __syncthreads();
    XcdBarrier bar; bar.bar = (unsigned*)(F.ctl + CW_BAR); bar.x = 0; bar.st = nullptr;
    if (MK_N_LAUNCHES == 1) bar = xcd_barrier_post((unsigned*)(F.ctl + CW_BAR), F.MISC + 8);
#define GRID_BAR() do { if (MK_N_LAUNCHES == 1) xcd_barrier(bar); } while (0)
    const int lo = args.ph_lo, hi = args.ph_hi;
#define PHON(j) (((MK_PHASE_MASK) >> (j)) & 1)
#define IN(k) (lo <= (k) && (k) < hi)
#define BOTH(k) (IN(k) && IN((k) + 1))

    bf16* const XB = (bf16*)(ws + WS_XB);
    bf16* const Z = (bf16*)(ws + WS_Z);
    bf16* const H = (bf16*)(ws + WS_Z);
    float* const R = args.out;

    if (PHON(0) && IN(0)) { p0_prologue(F, args); if (BOTH(0)) GRID_BAR(); }

    for (int l = 0; l < DEPTH; ++l) {
        const int pb = 1 + 8 * l;
        const bf16* WinT = (const bf16*)(ws + WS_WIN) + (size_t)l * NWIN * D;
        const bf16* WbT = (const bf16*)(ws + WS_WB) + (size_t)l * 3 * D * 512;
        const bf16* WoutT = (const bf16*)(ws + WS_WOUT) + (size_t)l * D * D;
        const bf16* WupT = (const bf16*)(ws + WS_WUP) + (size_t)l * FF * D;
        const bf16* WdnT = (const bf16*)(ws + WS_WDN) + (size_t)l * D * FF;

        if (PHON(1) && IN(pb + 0)) {
            pg8::Gemm g{XB, WinT, D, D, D}; pg8::StaticOrder S; S.init(M, ZW, F.G, (int)blockIdx.x);
            pg8::EpiBf16<0> E{Z, ZW};
            pg8::gemm_phase<pg8::EpiBf16<0>, pg8::StaticOrder, true>(F.lds, g, S, E);
            if (BOTH(pb + 0)) GRID_BAR();
        }
        if (PHON(2) && IN(pb + 1)) {
            const float lam_init = 0.8f - 0.6f * expf(-0.3f * (float)l);
            const float* lp = args.in[4] + l * 256;
            PHASE_IDS();
            const float lam = expf(wave_sum(lp[lane] * lp[64 + lane])) - expf(wave_sum(lp[128 + lane] * lp[192 + lane])) + lam_init;
            if (blockIdx.x < 128) {
                const int cu = blockIdx.x, bh = cu & 63;
                if (cu < 64) chain_naive_unit<0>(F, Z, bh >> 2, bh & 3, l, args);
                else chain_naive_unit<1>(F, Z, bh >> 2, bh & 3, l, args);
            }
            gu32* qhead = F.ctl + CW_QUEUE + 64 * l;
            for (;;) {
                __syncthreads();
                if (tid == 0) F.MISC[16] = __hip_atomic_fetch_add(qhead, 1u, RLX_AGENT);
                __syncthreads();
                const unsigned it = F.MISC[16];
                if (it >= 2048u) break;
                const int rb = 31 - (int)(it >> 6), bh = (int)(it & 63u);
                attn_naive_item(F, Z, bh >> 2, bh & 3, rb, lam, 1.0f - lam_init, args.in[5] + l * 128);
            }
            if (BOTH(pb + 1)) GRID_BAR();
        }
        if (PHON(3) && IN(pb + 2)) {
            pg8::StaticOrder S; S.init(M, D, F.G, (int)blockIdx.x);
            for (int n = 0; n < 3; ++n) {
                { pg8::Gemm g{XB, WinT + (size_t)(ZW + n * D) * D, D, D, D};
                  pg8::EpiBf16<1> E{Z + ZC_GATE, ZW};
                  pg8::gemm_phase<pg8::EpiBf16<1>, pg8::StaticOrder, true>(F.lds, g, S, E); }
                VM_WAIT(); __syncthreads();
                { const int boff = (n == 0) ? ZC_QA : (n == 1) ? ZC_VG : ZC_IH;
                  pg8::Gemm g{Z + boff, WbT + (size_t)n * D * 512, 512, ZW, 512};
                  pg8::EpiMerge E{Z + ZC_MRG, Z + ZC_GATE, ZW, n == 0 ? 1 : 0};
                  pg8::gemm_phase<pg8::EpiMerge, pg8::StaticOrder, true>(F.lds, g, S, E); }
                VM_WAIT(); __syncthreads();
            }
            if (BOTH(pb + 2)) GRID_BAR();
        }
        if (PHON(4) && IN(pb + 3)) {
            pg8::Gemm g{Z + ZC_MRG, WoutT, D, ZW, D}; pg8::StaticOrder S; S.init(M, D, F.G, (int)blockIdx.x);
            pg8::EpiResF32 E{l == 0 ? args.in[0] : R, R, D, ALPHA};
            pg8::gemm_phase<pg8::EpiResF32, pg8::StaticOrder, true>(F.lds, g, S, E);
            if (BOTH(pb + 3)) GRID_BAR();
        }
        if (PHON(5) && IN(pb + 4)) { ln_phase(F, R, XB, args.in[11] + l * D, args.in[12] + l * D); if (BOTH(pb + 4)) GRID_BAR(); }
        if (PHON(6) && IN(pb + 5)) {
            pg8::Gemm g{XB, WupT, D, D, D}; pg8::StaticOrder S; S.init(M, FF, F.G, (int)blockIdx.x);
            pg8::EpiBf16<2> E{H, FF};
            pg8::gemm_phase<pg8::EpiBf16<2>, pg8::StaticOrder, true>(F.lds, g, S, E);
            if (BOTH(pb + 5)) GRID_BAR();
        }
        if (PHON(7) && IN(pb + 6)) {
            pg8::Gemm g{H, WdnT, FF, FF, FF}; pg8::StaticOrder S; S.init(M, D, F.G, (int)blockIdx.x);
            pg8::EpiResF32 E{R, R, D, ALPHA};
            pg8::gemm_phase<pg8::EpiResF32, pg8::StaticOrder, true>(F.lds, g, S, E);
            if (BOTH(pb + 6)) GRID_BAR();
        }
        if (PHON(8) && IN(pb + 7)) { ln_phase(F, R, XB, args.in[15] + l * D, args.in[16] + l * D); if (BOTH(pb + 7)) GRID_BAR(); }
    }
#undef IN
#undef BOTH
#undef GRID_BAR
}

extern "C" void kernel_launch(void* const* d_in, const int* in_sizes, int n_in, void* d_out, int out_size, void* d_ws, size_t ws_size, hipStream_t stream) {
    static int grid = 0;
    if (grid == 0) {
        if (n_in != 17 || in_sizes[0] != M * D || out_size != M * D || ws_size < WS_END) { fprintf(stderr, "kernel_launch: unexpected shapes / workspace (n_in %d, ws %zu); nothing launched\n", n_in, ws_size); grid = -1; return; }
        int dev = 0, cus = 0, per_cu = 0;
        if (hipGetDevice(&dev) != hipSuccess || hipDeviceGetAttribute(&cus, hipDeviceAttributeMultiprocessorCount, dev) != hipSuccess) { grid = -1; return; }
        if (hipFuncSetAttribute((const void*)skel_fwd, hipFuncAttributeMaxDynamicSharedMemorySize, LDS_BYTES) != hipSuccess) { fprintf(stderr, "kernel_launch: hipFuncSetAttribute failed\n"); grid = -1; return; }
        if (hipOccupancyMaxActiveBlocksPerMultiprocessor(&per_cu, (const void*)skel_fwd, NWAVES * 64, LDS_BYTES) != hipSuccess || per_cu < 1)
            fprintf(stderr, "kernel_launch: note: occupancy query reports %d workgroups per CU\n", per_cu);
        (void)hipGetLastError();
        grid = cus;
    }
    if (grid < 0) return;
    if (hipMemsetAsync((char*)d_ws + WS_CTL, 0, CTL_ZERO_BYTES, stream) != hipSuccess) return;
    Args a{};
    for (int i = 0; i < 17; ++i) a.in[i] = (const float*)d_in[i];
    a.out = (float*)d_out; a.ws = (unsigned char*)d_ws;
    if (MK_N_LAUNCHES == 1) {
        a.ph_lo = 0; a.ph_hi = NPHASE;
        hipLaunchKernelGGL(skel_fwd, dim3(grid), dim3(NWAVES * 64), LDS_BYTES, stream, a);
    } else {
        for (int p = 0; p < NPHASE; ++p) { a.ph_lo = p; a.ph_hi = p + 1; hipLaunchKernelGGL(skel_fwd, dim3(grid), dim3(NWAVES * 64), LDS_BYTES, stream, a); }
    }
}
```

```cpp
#include <hip/hip_runtime.h>
#include <cstdio>
#include <cstdint>

#ifndef MK_N_LAUNCHES
#define MK_N_LAUNCHES 1
#endif
#ifndef MK_PHASE_MASK
#define MK_PHASE_MASK 0x1ff
#endif

namespace pg8 {
#define PG8_LAS __attribute__((address_space(3)))
typedef unsigned short bf16_t;
typedef short bf16x8 __attribute__((ext_vector_type(8)));
typedef float f32x4 __attribute__((ext_vector_type(4)));
typedef unsigned u32x4 __attribute__((ext_vector_type(4)));
constexpr int BM = 256, BK = 64, HALF = 128, HTB = HALF * BK * 2, STAGE_BYTES = 8 * HTB, NXCD = 8, WGM = 8;

__host__ __device__ __forceinline__ int lds_byte(int r, int c) { const int st = (r >> 4) * 2 + (c >> 5), rr = r & 15, cc = c & 31, ob = rr * 64 + cc * 2; return st * 1024 + (ob ^ (((ob >> 9) & 1) << 5)); }
__host__ __device__ __forceinline__ void stage_rc(int b, int& R, int& C) { const int st = b / 1024, sb = b % 1024, swz = sb ^ (((sb >> 9) & 1) << 5); R = (st >> 1) * 16 + swz / 64; C = (st & 1) * 32 + (swz % 64) / 2; }
__host__ __device__ __forceinline__ int perm32(int rho) { const int n = rho >> 4, i = rho & 15; return 8 * (i >> 2) + 4 * n + (i & 3); }

struct Unit { int pm, pn; };
struct Gemm { const bf16_t* A; const bf16_t* Bt; int K, lda, ldb; };

struct StaticOrder {
    int nM, nN, nwg, G, c;
    __host__ __device__ void init(int M, int N, int G_, int c_) { nM = M / BM; nN = N / BM; nwg = nM * nN; G = G_; c = c_; }
    __host__ __device__ bool next(int i, Unit& u) const {
        const long L = (long)i * G + c; if (L >= nwg) return false;
        int wgid = (int)L; { const int q = nwg / NXCD, r = nwg % NXCD, xcd = wgid % NXCD, off = wgid / NXCD; wgid = (xcd < r ? xcd * (q + 1) : r * (q + 1) + (xcd - r) * q) + off; }
        const int nig = WGM * nN, gid = wgid / nig, fm = gid * WGM, gsz = (nM - fm) < WGM ? (nM - fm) : WGM;
        u.pm = fm + ((wgid % nig) % gsz); u.pn = (wgid % nig) / gsz; return true;
    }
    __device__ __forceinline__ void a_ready(const Unit&) const {}
    __device__ __forceinline__ void done(const Unit&) const {}
};

__device__ __forceinline__ unsigned cvt_pk_bf16(float lo, float hi) { unsigned r; asm volatile("v_cvt_pk_bf16_f32 %0, %1, %2" : "=v"(r) : "v"(lo), "v"(hi)); return r; }
__device__ __forceinline__ float bflo(unsigned w) { return __uint_as_float(w << 16); }
__device__ __forceinline__ float bfhi(unsigned w) { return __uint_as_float(w & 0xffff0000u); }

template <int ACT> struct EpiBf16 {
    static constexpr bool PERM = true;
    bf16_t* O; int ldc;
    __device__ __forceinline__ float act(float v) const {
        if (ACT == 1) return 1.0f / (1.0f + __expf(-v));
        if (ACT == 2) { const float r = fmaxf(v, 0.f); return r * r; }
        return v;
    }
    __device__ __forceinline__ void operator()(const f32x4 (&acc)[2][2][4][2], const Unit& u, int wr, int wc, int fr, int fq) const {
        const int row0 = u.pm * BM + wr * 64 + fr, col0 = u.pn * BM + wc * 32 + 8 * fq;
#pragma unroll
        for (int ai = 0; ai < 2; ++ai)
#pragma unroll
            for (int m = 0; m < 4; ++m) { bf16_t* rowp = O + (size_t)(row0 + ai * HALF + m * 16) * ldc + col0;
#pragma unroll
                for (int bj = 0; bj < 2; ++bj) { const f32x4 v0 = acc[ai][bj][m][0], v1 = acc[ai][bj][m][1];
                    u32x4 w; w.x = cvt_pk_bf16(act(v0[0]), act(v0[1])); w.y = cvt_pk_bf16(act(v0[2]), act(v0[3])); w.z = cvt_pk_bf16(act(v1[0]), act(v1[1])); w.w = cvt_pk_bf16(act(v1[2]), act(v1[3]));
                    *(u32x4*)(rowp + bj * HALF) = w; } }
    }
};
struct EpiMerge {
    static constexpr bool PERM = true;
    bf16_t* Mg; const bf16_t* Gt; int ldc; int first;
    __device__ __forceinline__ void operator()(const f32x4 (&acc)[2][2][4][2], const Unit& u, int wr, int wc, int fr, int fq) const {
        const int row0 = u.pm * BM + wr * 64 + fr, col0 = u.pn * BM + wc * 32 + 8 * fq;
#pragma unroll
        for (int ai = 0; ai < 2; ++ai)
#pragma unroll
            for (int m = 0; m < 4; ++m) { const size_t ro = (size_t)(row0 + ai * HALF + m * 16) * ldc + col0;
#pragma unroll
                for (int bj = 0; bj < 2; ++bj) { const f32x4 v0 = acc[ai][bj][m][0], v1 = acc[ai][bj][m][1];
                    const u32x4 g = *(const u32x4*)(Gt + ro + bj * HALF);
                    u32x4 p = (u32x4){0u, 0u, 0u, 0u}; if (!first) p = *(const u32x4*)(Mg + ro + bj * HALF);
                    u32x4 w;
                    w.x = cvt_pk_bf16(bflo(p.x) + bflo(g.x) * v0[0], bfhi(p.x) + bfhi(g.x) * v0[1]);
                    w.y = cvt_pk_bf16(bflo(p.y) + bflo(g.y) * v0[2], bfhi(p.y) + bfhi(g.y) * v0[3]);
                    w.z = cvt_pk_bf16(bflo(p.z) + bflo(g.z) * v1[0], bfhi(p.z) + bfhi(g.z) * v1[1]);
                    w.w = cvt_pk_bf16(bflo(p.w) + bflo(g.w) * v1[2], bfhi(p.w) + bfhi(g.w) * v1[3]);
                    *(u32x4*)(Mg + ro + bj * HALF) = w; } }
    }
};
struct EpiResF32 {
    static constexpr bool PERM = false;
    const float* base; float* out; int ldc; float alpha;
    __device__ __forceinline__ void operator()(const f32x4 (&acc)[2][2][4][2], const Unit& u, int wr, int wc, int fr, int fq) const {
        const int row0 = u.pm * BM + wr * 64 + fr, col0 = u.pn * BM + wc * 32 + 4 * fq;
#pragma unroll
        for (int ai = 0; ai < 2; ++ai)
#pragma unroll
            for (int m = 0; m < 4; ++m) { const size_t ro = (size_t)(row0 + ai * HALF + m * 16) * ldc + col0;
#pragma unroll
                for (int bj = 0; bj < 2; ++bj)
#pragma unroll
                    for (int n = 0; n < 2; ++n) { const f32x4 bs = *(const f32x4*)(base + ro + bj * HALF + n * 16);
                        *(f32x4*)(out + ro + bj * HALF + n * 16) = bs * alpha + acc[ai][bj][m][n]; } }
    }
};

template <class Epi, class Sched, bool ALIGN_EPI = false>
__device__ __forceinline__ void gemm_phase(PG8_LAS unsigned char* lds, const Gemm g, const Sched& S, const Epi& E) {
    int tid_ = threadIdx.x; asm volatile("" : "+v"(tid_));
    const int tid = tid_, wid = __builtin_amdgcn_readfirstlane(tid >> 6), lane = tid & 63, wr = wid >> 2, wc = wid & 3, fr = lane & 15, fq = lane >> 4;
    const int K = g.K, nt = K / BK;
    unsigned voffA[2], voffB[2];
#pragma unroll
    for (int i = 0; i < 2; ++i) { int R, C; stage_rc(tid * 16 + i * 8192, R, C); const int Rb = Epi::PERM ? ((R & ~31) + perm32(R & 31)) : R;
        voffA[i] = (unsigned)(R * g.lda + C) * 2u; voffB[i] = (unsigned)(Rb * g.ldb + C) * 2u; }
    const size_t kstep = (size_t)(BK * 2);
    const size_t hstepA = (size_t)HALF * g.lda * 2, hstepB = (size_t)HALF * g.ldb * 2;
    const size_t tstepA = 2 * hstepA, tstepB = 2 * hstepB;
    const unsigned ldsw = (unsigned)wid * 1024u;
    const int aoff = lds_byte(wr * 64 + fr, fq * 8), boff = lds_byte(wc * 32 + fr, fq * 8);
#define PG8_SA(b, h) (((b) * 2 + (h)) * HTB)
#define PG8_SB(b, h) ((4 + (b) * 2 + (h)) * HTB)
#define PG8_STAGE(bufoff, gbase, voff) do { _Pragma("unroll") for (int _i = 0; _i < 2; ++_i) \
        __builtin_amdgcn_global_load_lds((const unsigned*)((const char*)(gbase) + (voff)[_i]), (PG8_LAS unsigned*)(lds + (bufoff) + ldsw + _i * 8192), 16, 0, 0); } while (0)
#define PG8_LDA(dst, b, h) do { _Pragma("unroll") for (int m = 0; m < 4; ++m) _Pragma("unroll") for (int k = 0; k < 2; ++k) dst[m][k] = *(const PG8_LAS bf16x8*)(lds + PG8_SA(b, h) + aoff + m * 2048 + k * 1024); } while (0)
#define PG8_LDB(dst, b, h) do { _Pragma("unroll") for (int n = 0; n < 2; ++n) _Pragma("unroll") for (int k = 0; k < 2; ++k) dst[n][k] = *(const PG8_LAS bf16x8*)(lds + PG8_SB(b, h) + boff + n * 2048 + k * 1024); } while (0)
#define PG8_MMA(ai, bj, At, Bt) do { __builtin_amdgcn_s_setprio(1); _Pragma("unroll") for (int m = 0; m < 4; ++m) _Pragma("unroll") for (int n = 0; n < 2; ++n) _Pragma("unroll") for (int k = 0; k < 2; ++k) \
        acc[ai][bj][m][n] = __builtin_amdgcn_mfma_f32_16x16x32_bf16(Bt[n][k], At[m][k], acc[ai][bj][m][n], 0, 0, 0); __builtin_amdgcn_s_setprio(0); } while (0)
#define PG8_WAIT_V(n) asm volatile("s_waitcnt vmcnt(" #n ")" ::: "memory")
#define PG8_WAIT_L(n) asm volatile("s_waitcnt lgkmcnt(" #n ")" ::: "memory")
#define PG8_BAR __builtin_amdgcn_s_barrier()
#define PG8_SCHED __builtin_amdgcn_sched_barrier(0)
    Unit cur, nxt; int ui = 0;
    if (!S.next(0, cur)) return;
    f32x4 acc[2][2][4][2];
#pragma unroll
    for (int a = 0; a < 2; ++a)
#pragma unroll
        for (int b = 0; b < 2; ++b)
#pragma unroll
            for (int m = 0; m < 4; ++m)
#pragma unroll
                for (int n = 0; n < 2; ++n) acc[a][b][m][n] = (f32x4){0.f, 0.f, 0.f, 0.f};
    bf16x8 At[4][2], B0[2][2], B1[2][2];
    const char* cA = (const char*)g.A + (size_t)cur.pm * tstepA; const char* cB = (const char*)g.Bt + (size_t)cur.pn * tstepB;
    S.a_ready(cur);
    PG8_STAGE(PG8_SB(0, 0), cB, voffB); PG8_STAGE(PG8_SB(0, 1), cB + hstepB, voffB); PG8_STAGE(PG8_SA(0, 0), cA, voffA); PG8_STAGE(PG8_SA(0, 1), cA + hstepA, voffA);
    if (wr == 1) PG8_BAR;
    PG8_WAIT_V(2); PG8_BAR;
    PG8_STAGE(PG8_SB(1, 0), cB + kstep, voffB); PG8_STAGE(PG8_SA(1, 0), cA + kstep, voffA); PG8_STAGE(PG8_SB(1, 1), cB + hstepB + kstep, voffB);
    PG8_WAIT_V(6); PG8_BAR;
    for (;;) {
        const bool has_next = S.next(ui + 1, nxt);
        const char* nA = has_next ? (const char*)g.A + (size_t)nxt.pm * tstepA : cA; const char* nB = has_next ? (const char*)g.Bt + (size_t)nxt.pn * tstepB : cB;
        for (int t = 0; t < nt; t += 2) {
            const bool last = (t == nt - 2);
            const char* a1 = cA + (size_t)(t + 1) * kstep;
            const char* a2 = last ? nA : cA + (size_t)(t + 2) * kstep; const char* b2 = last ? nB : cB + (size_t)(t + 2) * kstep;
            const char* a3 = a2 + kstep; const char* b3 = b2 + kstep;
            if (last && has_next) S.a_ready(nxt);
            PG8_LDB(B0, 0, 0); PG8_LDB(B1, 0, 1); PG8_SCHED; PG8_LDA(At, 0, 0); PG8_STAGE(PG8_SA(1, 1), a1 + hstepA, voffA);
            PG8_WAIT_V(8); PG8_WAIT_L(0); PG8_BAR; PG8_MMA(0, 0, At, B0); PG8_MMA(0, 1, At, B1); PG8_BAR; PG8_SCHED;
            PG8_LDA(At, 0, 1); PG8_STAGE(PG8_SB(0, 0), b2, voffB); PG8_STAGE(PG8_SB(0, 1), b2 + hstepB, voffB); PG8_STAGE(PG8_SA(0, 0), a2, voffA);
            PG8_WAIT_V(8); PG8_WAIT_L(0); PG8_BAR; PG8_MMA(1, 0, At, B0); PG8_MMA(1, 1, At, B1); PG8_BAR; PG8_SCHED;
            PG8_LDB(B0, 1, 0); PG8_LDB(B1, 1, 1); PG8_SCHED; PG8_LDA(At, 1, 0); PG8_STAGE(PG8_SA(0, 1), a2 + hstepA, voffA);
            PG8_WAIT_V(8); PG8_WAIT_L(0); PG8_BAR; PG8_MMA(0, 0, At, B0); PG8_MMA(0, 1, At, B1); PG8_BAR; PG8_SCHED;
            PG8_LDA(At, 1, 1); PG8_STAGE(PG8_SB(1, 0), b3, voffB); PG8_STAGE(PG8_SB(1, 1), b3 + hstepB, voffB); PG8_STAGE(PG8_SA(1, 0), a3, voffA);
            PG8_WAIT_V(8); PG8_WAIT_L(0); PG8_BAR; PG8_MMA(1, 0, At, B0); PG8_MMA(1, 1, At, B1); PG8_BAR; PG8_SCHED;
        }
        if constexpr (ALIGN_EPI) { if (wr == 0) PG8_BAR; }
        E(acc, cur, wr, wc, fr, fq); S.done(cur);
        if (!has_next) break;
#pragma unroll
        for (int a = 0; a < 2; ++a)
#pragma unroll
            for (int b = 0; b < 2; ++b)
#pragma unroll
                for (int m = 0; m < 4; ++m)
#pragma unroll
                    for (int n = 0; n < 2; ++n) acc[a][b][m][n] = (f32x4){0.f, 0.f, 0.f, 0.f};
        cur = nxt; cA = nA; cB = nB; ++ui;
        if constexpr (ALIGN_EPI) { if (wr == 1) PG8_BAR; }
    }
    PG8_WAIT_V(0);
    if constexpr (!ALIGN_EPI) { if (wr == 0) PG8_BAR; }
    PG8_BAR;
#undef PG8_SA
#undef PG8_SB
#undef PG8_STAGE
#undef PG8_LDA
#undef PG8_LDB
#undef PG8_MMA
#undef PG8_WAIT_V
#undef PG8_WAIT_L
#undef PG8_BAR
#undef PG8_SCHED
}
}

constexpr int NWAVES = 8;
constexpr int BATCH = 16, T = 2048, D = 1024, M = BATCH * T, FF = 4096, DEPTH = 2;
constexpr int IN_WIDTH = 8208;
constexpr int ZW = 5376;
constexpr int ZC_QA = 0, ZC_KA = 512, ZC_VA = 1024, ZC_QG = 1536, ZC_KG = 1792, ZC_VG = 2048, ZC_GO = 2560, ZC_QH = 3072, ZC_FH = 3584, ZC_IH = 4096, ZC_HO = 4608, ZC_GLR = 5120;
constexpr int ZC_MRG = 512;
constexpr int ZC_GATE = 3072;
constexpr int NWIN = ZW + 3 * D;
constexpr float LN_EPS = 1e-5f;
constexpr float ALPHA = 1.41421356237309515f;
constexpr int NPHASE = 1 + 8 * DEPTH;

constexpr size_t MiB = 1u << 20;
constexpr size_t WS_CTL = 0, CTL_ZERO_BYTES = 1 * MiB;
constexpr size_t WS_WIN = 1 * MiB;
constexpr size_t WS_WB = 34 * MiB;
constexpr size_t WS_WOUT = 40 * MiB;
constexpr size_t WS_WUP = 44 * MiB;
constexpr size_t WS_WDN = 60 * MiB;
constexpr size_t WS_XB = 76 * MiB;
constexpr size_t WS_Z = 140 * MiB;
constexpr size_t WS_END = 476 * MiB;
static_assert(WS_WIN + (size_t)DEPTH * NWIN * D * 2 <= WS_WB && WS_Z + (size_t)M * ZW * 2 <= WS_END, "d_ws map");
constexpr int CW_BAR = 4096;
constexpr int CW_QUEUE = 16384;

constexpr int RING_BYTES = 147456;
constexpr int LDSCTL_OFF = RING_BYTES, MISC_OFF = LDSCTL_OFF + 320;
constexpr int LDS_BYTES = RING_BYTES + 1024;

#define GAS __attribute__((address_space(1)))
#define LAS __attribute__((address_space(3)))
typedef unsigned short bf16;
typedef unsigned v4u __attribute__((ext_vector_type(4)));
typedef unsigned v2u __attribute__((ext_vector_type(2)));
typedef float f32x4 __attribute__((ext_vector_type(4)));
typedef GAS unsigned gu32;
#define RLX_AGENT __ATOMIC_RELAXED, __HIP_MEMORY_SCOPE_AGENT
#define LDS_WAIT() asm volatile("s_waitcnt lgkmcnt(0)" ::: "memory")
#define VM_WAIT() asm volatile("s_waitcnt vmcnt(0)" ::: "memory")
__device__ __forceinline__ unsigned f2bf(float f) { unsigned u = __builtin_bit_cast(unsigned, f); return (u + 0x7fffu + ((u >> 16) & 1u)) >> 16; }
__device__ __forceinline__ unsigned pk2(float lo, float hi) { return f2bf(lo) | (f2bf(hi) << 16); }
__device__ __forceinline__ float bf2f(unsigned short b) { return __uint_as_float((unsigned)b << 16); }
__device__ __forceinline__ float wave_sum(float v) {
#pragma unroll
    for (int o = 1; o < 64; o <<= 1) v += __shfl_xor(v, o);
    return v;
}
__device__ __forceinline__ float wave_max(float v) {
#pragma unroll
    for (int o = 1; o < 64; o <<= 1) v = fmaxf(v, __shfl_xor(v, o));
    return v;
}
__device__ __forceinline__ float logsigmoidf(float x) { return fminf(x, 0.f) - log1pf(expf(-fabsf(x))); }

#define XB_TMO      128
#define XB_XCNT(j)  (256  + 64 * (j))
#define XB_XSUB(j)  (1280 + 64 * (j))
#define XB_XGEN(j)  (2304 + 64 * (j))
#define XB_TOP      3328
#define XB_TOPGEN   3392
#define XCD_BAR_WORDS 3456
#define XB_SPIN_CAP (1u << 18)

__device__ __forceinline__ unsigned xb_ld(unsigned* p)              { return __hip_atomic_load(p, __ATOMIC_RELAXED, __HIP_MEMORY_SCOPE_AGENT); }
__device__ __forceinline__ unsigned xb_add(unsigned* p, unsigned v) { return __hip_atomic_fetch_add(p, v, __ATOMIC_RELAXED, __HIP_MEMORY_SCOPE_AGENT); }
__device__ __forceinline__ unsigned xb_xcc_id() { return (unsigned)__builtin_amdgcn_s_getreg((3 << 11) | 20) & 0xFu; }
#define XB_SPIN(cond, bar) do { unsigned _sp = 0; while (cond) { __builtin_amdgcn_s_sleep(1); \
    if ((++_sp & 255u) == 0u) { if (xb_ld(&(bar)[XB_TMO])) break; if (_sp > XB_SPIN_CAP) { atomicAdd(&(bar)[XB_TMO], 1u); break; } } } } while (0)

struct XcdBarrier {
    unsigned* bar; unsigned x;
    volatile LAS unsigned* st;
};
__device__ __forceinline__ XcdBarrier xcd_barrier_post(unsigned* bar, volatile LAS unsigned* st) {
    XcdBarrier b; b.bar = bar; b.x = xb_xcc_id(); b.st = st;
    if (threadIdx.x == 0) (void)xb_add(&bar[XB_XCNT(b.x)], 1u);
    return b;
}
__device__ __forceinline__ void xcd_barrier_complete(unsigned* bar, unsigned x, unsigned& nloc, unsigned& nx) {
    const unsigned G = gridDim.x * gridDim.y * gridDim.z;
    unsigned sum, cnt, mine, sp = 0u;
    for (;;) {
        sum = 0u; cnt = 0u; mine = 0u;
#pragma unroll
        for (unsigned j = 0; j < 16; ++j) { const unsigned c = xb_ld(&bar[XB_XCNT(j)]); sum += c; cnt += (c > 0u) ? 1u : 0u; mine = (j == x) ? c : mine; }
        if (sum == G) break;
        __builtin_amdgcn_s_sleep(1);
        if ((++sp & 255u) == 0u) { if (xb_ld(&bar[XB_TMO])) break; if (sp > XB_SPIN_CAP) { atomicAdd(&bar[XB_TMO], 1u); break; } }
    }
    nloc = mine > 0u ? mine : 1u; nx = cnt > 0u ? cnt : 1u;
}
__device__ __forceinline__ void xcd_barrier(const XcdBarrier& b) {
    asm volatile("s_waitcnt vmcnt(0)" ::: "memory");
    __syncthreads();
    if (threadIdx.x == 0) {
        unsigned* bar = b.bar;
        __builtin_amdgcn_s_waitcnt(0);
        unsigned nloc = b.st[0], nx = b.st[1];
        if (nloc == 0u) { xcd_barrier_complete(bar, b.x, nloc, nx); b.st[0] = nloc; b.st[1] = nx; }
        const unsigned old = xb_add(&bar[XB_XSUB(b.x)], 1u);
        const unsigned gen = old / nloc;
        if (old + 1u == (gen + 1u) * nloc) {
            __builtin_amdgcn_fence(__ATOMIC_RELEASE, "agent");
            asm volatile("s_waitcnt vmcnt(0)" ::: "memory");
            const unsigned og = xb_add(&bar[XB_TOP], 1u);
            const unsigned tg = og / nx;
            if (og + 1u == (tg + 1u) * nx) xb_add(&bar[XB_TOPGEN], 1u);
            else XB_SPIN(xb_ld(&bar[XB_TOPGEN]) == tg, bar);
            __builtin_amdgcn_fence(__ATOMIC_ACQUIRE, "agent");
            xb_add(&bar[XB_XGEN(b.x)], 1u);
            asm volatile("s_waitcnt vmcnt(0)" ::: "memory");
        } else {
            XB_SPIN(xb_ld(&bar[XB_XGEN(b.x)]) == gen, bar);
            __builtin_amdgcn_fence(__ATOMIC_ACQUIRE, "agent");
            asm volatile("s_waitcnt vmcnt(0)" ::: "memory");
        }
    }
    __syncthreads();
}

struct Frame {
    LAS unsigned char* lds;
    volatile LAS unsigned* MISC;
    gu32* ctl;
    int vcu, G;
};
#define PHASE_IDS() int tid_o_ = threadIdx.x; asm volatile("" : "+v"(tid_o_)); const int tid = tid_o_, lane = tid & 63, wave = __builtin_amdgcn_readfirstlane(tid >> 6); (void)tid; (void)lane; (void)wave

__device__ __forceinline__ int win_src_col(int j) {
    if (j < 2560) return j;
    if (j < 5120) return j + 16;
    if (j < 5136) return j - 5120 + 2560;
    if (j < ZW) return -1;
    return j - ZW + 5136;
}
template <bool MAPWIN>
__device__ __forceinline__ void p0_transpose_item(const float* W, int K, int Nsrc, int Ndst, bf16* WT, LAS float* scr, int item, int lane) {
    const int nblk = Ndst / 32, kb = item / nblk, nb = item % nblk, k0 = 64 * kb, n0 = 32 * nb;
    const int nd = n0 + (lane & 31); const int sc = MAPWIN ? win_src_col(nd) : nd;
#pragma unroll 8
    for (int i = 0; i < 32; ++i) { const int kk = 2 * i + (lane >> 5); scr[kk * 33 + (lane & 31)] = (sc >= 0) ? W[(size_t)(k0 + kk) * Nsrc + sc] : 0.f; }
    LDS_WAIT(); asm volatile("" ::: "memory");
    const int c = lane & 7;
#pragma unroll
    for (int j = 0; j < 4; ++j) { const int n = (lane >> 3) + 8 * j; const LAS float* s = scr + (8 * c) * 33 + n;
        v4u o; o.x = pk2(s[0 * 33], s[1 * 33]); o.y = pk2(s[2 * 33], s[3 * 33]); o.z = pk2(s[4 * 33], s[5 * 33]); o.w = pk2(s[6 * 33], s[7 * 33]);
        *(GAS v4u*)(WT + (size_t)(n0 + n) * K + k0 + 8 * c) = o; }
    LDS_WAIT(); asm volatile("" ::: "memory");
}

struct Args { const float* in[17]; float* out; unsigned char* ws; int ph_lo, ph_hi; };

__device__ __forceinline__ void p0_prologue(Frame& F, const Args& a) {
    PHASE_IDS();
    LAS float* scr = (LAS float*)(F.lds + wave * 16384);
    const int gw = F.vcu * NWAVES + wave, NGW = F.G * NWAVES;
    constexpr int I_IN = (D / 64) * (NWIN / 32), I_BR = (512 / 64) * (D / 32), I_OUT = (D / 64) * (D / 32), I_UP = (D / 64) * (FF / 32), I_DN = (FF / 64) * (D / 32);
    constexpr int PER_LAYER = I_IN + 3 * I_BR + I_OUT + I_UP + I_DN;
    for (int it = gw; it < DEPTH * PER_LAYER; it += NGW) {
        const int l = it / PER_LAYER; int r = it % PER_LAYER;
        if (r < I_IN) { p0_transpose_item<true>(a.in[1] + (size_t)l * D * IN_WIDTH, D, IN_WIDTH, NWIN, (bf16*)(a.ws + WS_WIN) + (size_t)l * NWIN * D, scr, r, lane); continue; } r -= I_IN;
        if (r < 3 * I_BR) { const int n = r / I_BR; p0_transpose_item<false>(a.in[9] + (size_t)(l * 3 + n) * 512 * D, 512, D, D, (bf16*)(a.ws + WS_WB) + (size_t)(l * 3 + n) * D * 512, scr, r % I_BR, lane); continue; } r -= 3 * I_BR;
        if (r < I_OUT) { p0_transpose_item<false>(a.in[10] + (size_t)l * D * D, D, D, D, (bf16*)(a.ws + WS_WOUT) + (size_t)l * D * D, scr, r, lane); continue; } r -= I_OUT;
        if (r < I_UP) { p0_transpose_item<false>(a.in[13] + (size_t)l * D * FF, D, FF, FF, (bf16*)(a.ws + WS_WUP) + (size_t)l * FF * D, scr, r, lane); continue; } r -= I_UP;
        p0_transpose_item<false>(a.in[14] + (size_t)l * FF * D, FF, D, D, (bf16*)(a.ws + WS_WDN) + (size_t)l * D * FF, scr, r, lane);
    }
    const float* x = a.in[0]; bf16* XB = (bf16*)(a.ws + WS_XB);
    for (int m = gw; m < M; m += NGW) {
        const GAS f32x4* xr = (const GAS f32x4*)(x + (size_t)m * D) + lane;
        GAS unsigned long long* o8 = (GAS unsigned long long*)(XB + (size_t)m * D) + lane;
#pragma unroll
        for (int j = 0; j < 4; ++j) { const f32x4 v = xr[64 * j]; o8[64 * j] = (unsigned long long)pk2(v.x, v.y) | ((unsigned long long)pk2(v.z, v.w) << 32); }
    }
}

__device__ __forceinline__ void ln_phase(Frame& F, float* R, bf16* XB, const float* w, const float* b) {
    PHASE_IDS();
    const int gw = F.vcu * NWAVES + wave, NGW = F.G * NWAVES;
    f32x4 wv[4], bv[4];
#pragma unroll
    for (int j = 0; j < 4; ++j) { wv[j] = ((const f32x4*)w)[lane + 64 * j]; bv[j] = ((const f32x4*)b)[lane + 64 * j]; }
    for (int m = gw; m < M; m += NGW) {
        GAS f32x4* xr = (GAS f32x4*)(R + (size_t)m * D) + lane;
        f32x4 v[4]; float s = 0.f;
#pragma unroll
        for (int j = 0; j < 4; ++j) { v[j] = xr[64 * j]; s += (v[j].x + v[j].y) + (v[j].z + v[j].w); }
        const float mean = wave_sum(s) * (1.f / D); float s2 = 0.f;
#pragma unroll
        for (int j = 0; j < 4; ++j) { v[j] = v[j] - mean; s2 += (v[j].x * v[j].x + v[j].y * v[j].y) + (v[j].z * v[j].z + v[j].w * v[j].w); }
        const float rstd = 1.f / sqrtf(wave_sum(s2) * (1.f / D) + LN_EPS);
        GAS unsigned long long* o8 = (GAS unsigned long long*)(XB + (size_t)m * D) + lane;
#pragma unroll
        for (int j = 0; j < 4; ++j) { const f32x4 y = v[j] * rstd * wv[j] + bv[j]; xr[64 * j] = y;
            o8[64 * j] = (unsigned long long)pk2(y.x, y.y) | ((unsigned long long)pk2(y.z, y.w) << 32); }
    }
}

__device__ __forceinline__ void attn_naive_item(Frame& F, bf16* Z, int b, int h, int rb, float lam, float post, const float* normw) {
    PHASE_IDS();
    LAS float* sb1 = (LAS float*)(F.lds + wave * 16384);
    LAS float* sb2 = sb1 + 2048;
    LAS float* qb = (LAS float*)(F.lds + 131072 + wave * 512);
    const float slope = exp2f(-2.0f * (float)(h + 1));
    const bf16* zb = Z + (size_t)b * T * ZW;
    for (int rr = 0; rr < 8; ++rr) {
        const int i = rb * 64 + wave * 8 + rr;
        const bf16* qrow = zb + (size_t)i * ZW + ZC_QA + h * 128;
        qb[lane] = bf2f(qrow[lane]) * 0.125f; qb[64 + lane] = bf2f(qrow[64 + lane]) * 0.125f;
        LDS_WAIT();
        float m1 = -1e30f, m2 = -1e30f;
        for (int j0 = 0; j0 <= i; j0 += 64) {
            const int j = j0 + lane;
            if (j <= i) {
                const bf16* krow = zb + (size_t)j * ZW + ZC_KA + h * 128;
                float d1 = 0.f, d2 = 0.f;
#pragma unroll
                for (int c = 0; c < 8; ++c) {
                    const v4u k1 = *(const v4u*)(krow + c * 8), k2 = *(const v4u*)(krow + 64 + c * 8);
                    const f32x4 qa = *(const LAS f32x4*)(qb + c * 8), qc = *(const LAS f32x4*)(qb + c * 8 + 4);
                    const f32x4 qd = *(const LAS f32x4*)(qb + 64 + c * 8), qe = *(const LAS f32x4*)(qb + 64 + c * 8 + 4);
                    d1 += qa.x * pg8::bflo(k1.x) + qa.y * pg8::bfhi(k1.x) + qa.z * pg8::bflo(k1.y) + qa.w * pg8::bfhi(k1.y)
                        + qc.x * pg8::bflo(k1.z) + qc.y * pg8::bfhi(k1.z) + qc.z * pg8::bflo(k1.w) + qc.w * pg8::bfhi(k1.w);
                    d2 += qd.x * pg8::bflo(k2.x) + qd.y * pg8::bfhi(k2.x) + qd.z * pg8::bflo(k2.y) + qd.w * pg8::bfhi(k2.y)
                        + qe.x * pg8::bflo(k2.z) + qe.y * pg8::bfhi(k2.z) + qe.z * pg8::bflo(k2.w) + qe.w * pg8::bfhi(k2.w);
                }
                const float bias = slope * (float)(i - j);
                const float s1 = d1 - bias, s2 = d2 - bias;
                sb1[j] = s1; sb2[j] = s2; m1 = fmaxf(m1, s1); m2 = fmaxf(m2, s2);
            }
        }
        m1 = wave_max(m1); m2 = wave_max(m2);
        float l1 = 0.f, l2 = 0.f;
        for (int j0 = 0; j0 <= i; j0 += 64) { const int j = j0 + lane;
            if (j <= i) { const float e1 = expf(sb1[j] - m1), e2 = expf(sb2[j] - m2); sb1[j] = e1; sb2[j] = e2; l1 += e1; l2 += e2; } }
        l1 = wave_sum(l1); l2 = wave_sum(l2);
        const float r1 = 1.0f / l1, r2 = lam / l2;
        for (int j0 = 0; j0 <= i; j0 += 64) { const int j = j0 + lane; if (j <= i) sb1[j] = sb1[j] * r1 - sb2[j] * r2; }
        LDS_WAIT();
        float a0 = 0.f, a1 = 0.f;
        const bf16* vcol = zb + ZC_VA + h * 128 + 2 * lane;
#pragma unroll 4
        for (int j = 0; j <= i; ++j) { const float a = sb1[j]; const unsigned vv = *(const unsigned*)(vcol + (size_t)j * ZW); a0 += a * pg8::bflo(vv); a1 += a * pg8::bfhi(vv); }
        const float ss = wave_sum(a0 * a0 + a1 * a1) * (1.0f / 128.0f);
        const float r = post / sqrtf(ss + LN_EPS);
        const float o0 = a0 * r * normw[2 * lane], o1 = a1 * r * normw[2 * lane + 1];
        *(GAS unsigned*)((bf16*)zb + (size_t)i * ZW + ZC_QA + h * 128 + 2 * lane) = pk2(o0, o1);
        LDS_WAIT();
    }
}

template <int MIXER>
__device__ __forceinline__ void chain_naive_unit(Frame& F, bf16* Z, int b, int h, int l, const Args& a) {
    constexpr int DK = MIXER == 0 ? 64 : 128, DKS = DK / 4, CH = 32;
    constexpr int ZQ = MIXER == 0 ? ZC_QG : ZC_QH, ZK = MIXER == 0 ? ZC_KG : ZC_FH, ZV = MIXER == 0 ? ZC_VG : ZC_IH, ZG = MIXER == 0 ? ZC_GO : ZC_HO;
    LAS float* ge = (LAS float*)F.lds;
    LAS float* qs = ge + CH * DK;
    LAS float* ks = qs + CH * DK;
    LAS float* vs = (LAS float*)(F.lds + 49152);
    LAS float* op = (LAS float*)(F.lds + 65536);
    PHASE_IDS();
    const int col = tid & 127, sl = tid >> 7;
    bf16* zb = Z + (size_t)b * T * ZW;
    const float* normw = (MIXER == 0 ? a.in[6] : a.in[7]) + l * 128;
    const float* Wg = a.in[2] + (size_t)l * 16 * 256; const float* bg = a.in[3] + l * 256;
    const float* lbp = a.in[8];
    float S[DKS];
#pragma unroll
    for (int d = 0; d < DKS; ++d) S[d] = 0.f;
    for (int c0 = 0; c0 < T; c0 += CH) {
        for (int idx = tid; idx < CH * DK; idx += 512) {
            const int t = idx / DK, d = idx % DK; const bf16* zr = zb + (size_t)(c0 + t) * ZW;
            float lg, kv, qv;
            if (MIXER == 0) {
                float pre = bg[h * 64 + d];
#pragma unroll
                for (int r = 0; r < 16; ++r) pre += bf2f(zr[ZC_GLR + r]) * Wg[r * 256 + h * 64 + d];
                lg = logsigmoidf(pre) * (1.0f / 16.0f); kv = bf2f(zr[ZK + h * DK + d]); qv = bf2f(zr[ZQ + h * DK + d]) * 0.125f;
            } else {
                const int c = h * 128 + d; const float x0 = lbp[c], x1 = lbp[512 + c], mx = fmaxf(x0, x1), e0 = expf(x0 - mx), e1 = expf(x1 - mx);
                const float lb = (l == 0) ? 0.f : e1 / (e0 + e1);
                const float aa = logf(fmaxf(lb, 1e-30f)), bb = log1pf(-lb) + logsigmoidf(bf2f(zr[ZK + c]));
                lg = fmaxf(aa, bb) + log1pf(expf(-fabsf(aa - bb))); kv = -expm1f(lg); qv = bf2f(zr[ZQ + c]);
            }
            ge[idx] = expf(lg); ks[idx] = kv; qs[idx] = qv;
        }
        for (int idx = tid; idx < CH * 128; idx += 512) { const int t = idx >> 7, c = idx & 127; vs[idx] = bf2f(zb[(size_t)(c0 + t) * ZW + ZV + h * 128 + c]); }
        __syncthreads();
        for (int t = 0; t < CH; ++t) {
            const float v = vs[t * 128 + col]; float o = 0.f;
#pragma unroll
            for (int d4 = 0; d4 < DKS; d4 += 4) {
                const f32x4 g4 = *(const LAS f32x4*)(ge + t * DK + sl * DKS + d4), k4 = *(const LAS f32x4*)(ks + t * DK + sl * DKS + d4), q4 = *(const LAS f32x4*)(qs + t * DK + sl * DKS + d4);
                S[d4 + 0] = g4.x * S[d4 + 0] + k4.x * v; o += q4.x * S[d4 + 0];
                S[d4 + 1] = g4.y * S[d4 + 1] + k4.y * v; o += q4.y * S[d4 + 1];
                S[d4 + 2] = g4.z * S[d4 + 2] + k4.z * v; o += q4.z * S[d4 + 2];
                S[d4 + 3] = g4.w * S[d4 + 3] + k4.w * v; o += q4.w * S[d4 + 3];
            }
            op[(sl * CH + t) * 128 + col] = o;
        }
        __syncthreads();
#pragma unroll
        for (int tt = 0; tt < 4; ++tt) {
            const int t = wave * 4 + tt, c = 2 * lane;
            float o0 = 0.f, o1 = 0.f;
#pragma unroll
            for (int s = 0; s < 4; ++s) { o0 += op[(s * CH + t) * 128 + c]; o1 += op[(s * CH + t) * 128 + c + 1]; }
            const float ss = wave_sum(o0 * o0 + o1 * o1) * (1.0f / 128.0f), r = 1.0f / sqrtf(ss + LN_EPS);
            bf16* zr = zb + (size_t)(c0 + t) * ZW;
            const unsigned gw2 = *(const unsigned*)(zr + ZG + h * 128 + c);
            const float g0 = pg8::bflo(gw2), g1 = pg8::bfhi(gw2);
            const float y0 = o0 * r * normw[c] * (g0 / (1.0f + expf(-g0))), y1 = o1 * r * normw[c + 1] * (g1 / (1.0f + expf(-g1)));
            *(GAS unsigned*)(zr + ZV + h * 128 + c) = pk2(y0, y1);
        }
        __syncthreads();
    }
}

__global__ void __launch_bounds__(NWAVES * 64, 2) skel_fwd(Args args) {
    extern __shared__ __attribute__((aligned(16))) unsigned char lds[];
    Frame F;
    F.lds = (LAS unsigned char*)lds;
    F.MISC = (volatile LAS unsigned*)(F.lds + MISC_OFF);
    F.G = gridDim.x; { const int bx = blockIdx.x; F.vcu = (F.G % 8 == 0) ? (bx % 8) * (F.G / 8) + bx / 8 : bx; }
    unsigned char* ws = args.ws;
    F.ctl = (gu32*)(ws + WS_CTL);
    for (int u = threadIdx.x; u < (LDS_BYTES - LDSCTL_OFF) / 4; u += NWAVES * 64) ((LAS unsigned*)(F.lds + LDSCTL_OFF))[u] = 0u;
    __syncthreads();
    XcdBarrier bar; bar.bar = (unsigned*)(F.ctl + CW_BAR); bar.x = 0; bar.st = nullptr;
    if (MK_N_LAUNCHES == 1) bar = xcd_barrier_post((unsigned*)(F.ctl + CW_BAR), F.MISC + 8);
#define GRID_BAR() do { if (MK_N_LAUNCHES == 1) xcd_barrier(bar); } while (0)
    const int lo = args.ph_lo, hi = args.ph_hi;
#define PHON(j) (((MK_PHASE_MASK) >> (j)) & 1)
#define IN(k) (lo <= (k) && (k) < hi)
#define BOTH(k) (IN(k) && IN((k) + 1))

    bf16* const XB = (bf16*)(ws + WS_XB);
    bf16* const Z = (bf16*)(ws + WS_Z);
    bf16* const H = (bf16*)(ws + WS_Z);
    float* const R = args.out;

    if (PHON(0) && IN(0)) { p0_prologue(F, args); if (BOTH(0)) GRID_BAR(); }

    for (int l = 0; l < DEPTH; ++l) {
        const int pb = 1 + 8 * l;
        const bf16* WinT = (const bf16*)(ws + WS_WIN) + (size_t)l * NWIN * D;
        const bf16* WbT = (const bf16*)(ws + WS_WB) + (size_t)l * 3 * D * 512;
        const bf16* WoutT = (const bf16*)(ws + WS_WOUT) + (size_t)l * D * D;
        const bf16* WupT = (const bf16*)(ws + WS_WUP) + (size_t)l * FF * D;
        const bf16* WdnT = (const bf16*)(ws + WS_WDN) + (size_t)l * D * FF;

        if (PHON(1) && IN(pb + 0)) {
            pg8::Gemm g{XB, WinT, D, D, D}; pg8::StaticOrder S; S.init(M, ZW, F.G, (int)blockIdx.x);
            pg8::EpiBf16<0> E{Z, ZW};
            pg8::gemm_phase<pg8::EpiBf16<0>, pg8::StaticOrder, true>(F.lds, g, S, E);
            if (BOTH(pb + 0)) GRID_BAR();
        }
        if (PHON(2) && IN(pb + 1)) {
            const float lam_init = 0.8f - 0.6f * expf(-0.3f * (float)l);
            const float* lp = args.in[4] + l * 256;
            PHASE_IDS();
            const float lam = expf(wave_sum(lp[lane] * lp[64 + lane])) - expf(wave_sum(lp[128 + lane] * lp[192 + lane])) + lam_init;
            if (blockIdx.x < 128) {
                const int cu = blockIdx.x, bh = cu & 63;
                if (cu < 64) chain_naive_unit<0>(F, Z, bh >> 2, bh & 3, l, args);
                else chain_naive_unit<1>(F, Z, bh >> 2, bh & 3, l, args);
            }
            gu32* qhead = F.ctl + CW_QUEUE + 64 * l;
            for (;;) {
                __syncthreads();
                if (tid == 0) F.MISC[16] = __hip_atomic_fetch_add(qhead, 1u, RLX_AGENT);
                __syncthreads();
                const unsigned it = F.MISC[16];
                if (it >= 2048u) break;
                const int rb = 31 - (int)(it >> 6), bh = (int)(it & 63u);
                attn_naive_item(F, Z, bh >> 2, bh & 3, rb, lam, 1.0f - lam_init, args.in[5] + l * 128);
            }
            if (BOTH(pb + 1)) GRID_BAR();
        }
        if (PHON(3) && IN(pb + 2)) {
            pg8::StaticOrder S; S.init(M, D, F.G, (int)blockIdx.x);
            for (int n = 0; n < 3; ++n) {
                { pg8::Gemm g{XB, WinT + (size_t)(ZW + n * D) * D, D, D, D};
                  pg8::EpiBf16<1> E{Z + ZC_GATE, ZW};
                  pg8::gemm_phase<pg8::EpiBf16<1>, pg8::StaticOrder, true>(F.lds, g, S, E); }
                VM_WAIT(); __syncthreads();
                { const int boff = (n == 0) ? ZC_QA : (n == 1) ? ZC_VG : ZC_IH;
                  pg8::Gemm g{Z + boff, WbT + (size_t)n * D * 512, 512, ZW, 512};
                  pg8::EpiMerge E{Z + ZC_MRG, Z + ZC_GATE, ZW, n == 0 ? 1 : 0};
                  pg8::gemm_phase<pg8::EpiMerge, pg8::StaticOrder, true>(F.lds, g, S, E); }
                VM_WAIT(); __syncthreads();
            }
            if (BOTH(pb + 2)) GRID_BAR();
        }
        if (PHON(4) && IN(pb + 3)) {
            pg8::Gemm g{Z + ZC_MRG, WoutT, D, ZW, D}; pg8::StaticOrder S; S.init(M, D, F.G, (int)blockIdx.x);
            pg8::EpiResF32 E{l == 0 ? args.in[0] : R, R, D, ALPHA};
            pg8::gemm_phase<pg8::EpiResF32, pg8::StaticOrder, true>(F.lds, g, S, E);
            if (BOTH(pb + 3)) GRID_BAR();
        }
        if (PHON(5) && IN(pb + 4)) { ln_phase(F, R, XB, args.in[11] + l * D, args.in[12] + l * D); if (BOTH(pb + 4)) GRID_BAR(); }
        if (PHON(6) && IN(pb + 5)) {
            pg8::Gemm g{XB, WupT, D, D, D}; pg8::StaticOrder S; S.init(M, FF, F.G, (int)blockIdx.x);
            pg8::EpiBf16<2> E{H, FF};
            pg8::gemm_phase<pg8::EpiBf16<2>, pg8::StaticOrder, true>(F.lds, g, S, E);
            if (BOTH(pb + 5)) GRID_BAR();
        }
        if (PHON(7) && IN(pb + 6)) {
            pg8::Gemm g{H, WdnT, FF, FF, FF}; pg8::StaticOrder S; S.init(M, D, F.G, (int)blockIdx.x);
            pg8::EpiResF32 E{R, R, D, ALPHA};
            pg8::gemm_phase<pg8::EpiResF32, pg8::StaticOrder, true>(F.lds, g, S, E);
            if (BOTH(pb + 6)) GRID_BAR();
        }
        if (PHON(8) && IN(pb + 7)) { ln_phase(F, R, XB, args.in[15] + l * D, args.in[16] + l * D); if (BOTH(pb + 7)) GRID_BAR(); }
    }
#undef IN
#undef BOTH
#undef GRID_BAR
}

extern "C" void kernel_launch(void* const* d_in, const int* in_sizes, int n_in, void* d_out, int out_size, void* d_ws, size_t ws_size, hipStream_t stream) {
    static int grid = 0;
    if (grid == 0) {
        if (n_in != 17 || in_sizes[0] != M * D || out_size != M * D || ws_size < WS_END) { fprintf(stderr, "kernel_launch: unexpected shapes / workspace (n_in %d, ws %zu); nothing launched\n", n_in, ws_size); grid = -1; return; }
        int dev = 0, cus = 0, per_cu = 0;
        if (hipGetDevice(&dev) != hipSuccess || hipDeviceGetAttribute(&cus, hipDeviceAttributeMultiprocessorCount, dev) != hipSuccess) { grid = -1; return; }
        if (hipFuncSetAttribute((const void*)skel_fwd, hipFuncAttributeMaxDynamicSharedMemorySize, LDS_BYTES) != hipSuccess) { fprintf(stderr, "kernel_launch: hipFuncSetAttribute failed\n"); grid = -1; return; }
        if (hipOccupancyMaxActiveBlocksPerMultiprocessor(&per_cu, (const void*)skel_fwd, NWAVES * 64, LDS_BYTES) != hipSuccess || per_cu < 1)
            fprintf(stderr, "kernel_launch: note: occupancy query reports %d workgroups per CU\n", per_cu);
        (void)hipGetLastError();
        grid = cus;
    }
    if (grid < 0) return;
    if (hipMemsetAsync((char*)d_ws + WS_CTL, 0, CTL_ZERO_BYTES, stream) != hipSuccess) return;
    Args a{};
    for (int i = 0; i < 17; ++i) a.in[i] = (const float*)d_in[i];
    a.out = (float*)d_out; a.ws = (unsigned char*)d_ws;
    if (MK_N_LAUNCHES == 1) {
        a.ph_lo = 0; a.ph_hi = NPHASE;
        hipLaunchKernelGGL(skel_fwd, dim3(grid), dim3(NWAVES * 64), LDS_BYTES, stream, a);
    } else {
        for (int p = 0; p < NPHASE; ++p) { a.ph_lo = p; a.ph_hi = p + 1; hipLaunchKernelGGL(skel_fwd, dim3(grid), dim3(NWAVES * 64), LDS_BYTES, stream, a); }
    }
}
```

```cpp
#include <hip/hip_runtime.h>
#include <cstdio>
#include <cstdint>

#ifndef MK_N_LAUNCHES
#define MK_N_LAUNCHES 1
#endif
#ifndef MK_PHASE_MASK
#define MK_PHASE_MASK 0x1ff
#endif

namespace pg8 {
#define PG8_LAS __attribute__((address_space(3)))
typedef unsigned short bf16_t;
typedef short bf16x8 __attribute__((ext_vector_type(8)));
typedef float f32x4 __attribute__((ext_vector_type(4)));
typedef unsigned u32x4 __attribute__((ext_vector_type(4)));
constexpr int BM = 256, BK = 64, HALF = 128, HTB = HALF * BK * 2, STAGE_BYTES = 8 * HTB, NXCD = 8, WGM = 8;

__host__ __device__ __forceinline__ int lds_byte(int r, int c) { const int st = (r >> 4) * 2 + (c >> 5), rr = r & 15, cc = c & 31, ob = rr * 64 + cc * 2; return st * 1024 + (ob ^ (((ob >> 9) & 1) << 5)); }
__host__ __device__ __forceinline__ void stage_rc(int b, int& R, int& C) { const int st = b / 1024, sb = b % 1024, swz = sb ^ (((sb >> 9) & 1) << 5); R = (st >> 1) * 16 + swz / 64; C = (st & 1) * 32 + (swz % 64) / 2; }
__host__ __device__ __forceinline__ int perm32(int rho) { const int n = rho >> 4, i = rho & 15; return 8 * (i >> 2) + 4 * n + (i & 3); }

struct Unit { int pm, pn; };
struct Gemm { const bf16_t* A; const bf16_t* Bt; int K, lda, ldb; };

struct StaticOrder {
    int nM, nN, nwg, G, c;
    __host__ __device__ void init(int M, int N, int G_, int c_) { nM = M / BM; nN = N / BM; nwg = nM * nN; G = G_; c = c_; }
    __host__ __device__ bool next(int i, Unit& u) const {
        const long L = (long)i * G + c; if (L >= nwg) return false;
        int wgid = (int)L; { const int q = nwg / NXCD, r = nwg % NXCD, xcd = wgid % NXCD, off = wgid / NXCD; wgid = (xcd < r ? xcd * (q + 1) : r * (q + 1) + (xcd - r) * q) + off; }
        const int nig = WGM * nN, gid = wgid / nig, fm = gid * WGM, gsz = (nM - fm) < WGM ? (nM - fm) : WGM;
        u.pm = fm + ((wgid % nig) % gsz); u.pn = (wgid % nig) / gsz; return true;
    }
    __device__ __forceinline__ void a_ready(const Unit&) const {}
    __device__ __forceinline__ void done(const Unit&) const {}
};

__device__ __forceinline__ unsigned cvt_pk_bf16(float lo, float hi) { unsigned r; asm volatile("v_cvt_pk_bf16_f32 %0, %1, %2" : "=v"(r) : "v"(lo), "v"(hi)); return r; }
__device__ __forceinline__ float bflo(unsigned w) { return __uint_as_float(w << 16); }
__device__ __forceinline__ float bfhi(unsigned w) { return __uint_as_float(w & 0xffff0000u); }

template <int ACT> struct EpiBf16 {
    static constexpr bool PERM = true;
    bf16_t* O; int ldc;
    __device__ __forceinline__ float act(float v) const {
        if (ACT == 1) return 1.0f / (1.0f + __expf(-v));
        if (ACT == 2) { const float r = fmaxf(v, 0.f); return r * r; }
        return v;
    }
    __device__ __forceinline__ void operator()(const f32x4 (&acc)[2][2][4][2], const Unit& u, int wr, int wc, int fr, int fq) const {
        const int row0 = u.pm * BM + wr * 64 + fr, col0 = u.pn * BM + wc * 32 + 8 * fq;
#pragma unroll
        for (int ai = 0; ai < 2; ++ai)
#pragma unroll
            for (int m = 0; m < 4; ++m) { bf16_t* rowp = O + (size_t)(row0 + ai * HALF + m * 16) * ldc + col0;
#pragma unroll
                for (int bj = 0; bj < 2; ++bj) { const f32x4 v0 = acc[ai][bj][m][0], v1 = acc[ai][bj][m][1];
                    u32x4 w; w.x = cvt_pk_bf16(act(v0[0]), act(v0[1])); w.y = cvt_pk_bf16(act(v0[2]), act(v0[3])); w.z = cvt_pk_bf16(act(v1[0]), act(v1[1])); w.w = cvt_pk_bf16(act(v1[2]), act(v1[3]));
                    *(u32x4*)(rowp + bj * HALF) = w; } }
    }
};
struct EpiZ {
    static constexpr bool PERM = true;
    bf16_t* O; int ldc; int nq; float qscale;
    __device__ __forceinline__ void operator()(const f32x4 (&acc)[2][2][4][2], const Unit& u, int wr, int wc, int fr, int fq) const {
        const int row0 = u.pm * BM + wr * 64 + fr, col0 = u.pn * BM + wc * 32 + 8 * fq;
        const float sc = (u.pn < nq) ? qscale : 1.0f;
#pragma unroll
        for (int ai = 0; ai < 2; ++ai)
#pragma unroll
            for (int m = 0; m < 4; ++m) { bf16_t* rowp = O + (size_t)(row0 + ai * HALF + m * 16) * ldc + col0;
#pragma unroll
                for (int bj = 0; bj < 2; ++bj) { const f32x4 v0 = acc[ai][bj][m][0] * sc, v1 = acc[ai][bj][m][1] * sc;
                    u32x4 w; w.x = cvt_pk_bf16(v0[0], v0[1]); w.y = cvt_pk_bf16(v0[2], v0[3]); w.z = cvt_pk_bf16(v1[0], v1[1]); w.w = cvt_pk_bf16(v1[2], v1[3]);
                    *(u32x4*)(rowp + bj * HALF) = w; } }
    }
};
struct EpiMerge {
    static constexpr bool PERM = true;
    bf16_t* Mg; const bf16_t* Gt; int ldc; int first;
    __device__ __forceinline__ void operator()(const f32x4 (&acc)[2][2][4][2], const Unit& u, int wr, int wc, int fr, int fq) const {
        const int row0 = u.pm * BM + wr * 64 + fr, col0 = u.pn * BM + wc * 32 + 8 * fq;
#pragma unroll
        for (int ai = 0; ai < 2; ++ai)
#pragma unroll
            for (int m = 0; m < 4; ++m) { const size_t ro = (size_t)(row0 + ai * HALF + m * 16) * ldc + col0;
#pragma unroll
                for (int bj = 0; bj < 2; ++bj) { const f32x4 v0 = acc[ai][bj][m][0], v1 = acc[ai][bj][m][1];
                    const u32x4 g = *(const u32x4*)(Gt + ro + bj * HALF);
                    u32x4 p = (u32x4){0u, 0u, 0u, 0u}; if (!first) p = *(const u32x4*)(Mg + ro + bj * HALF);
                    u32x4 w;
                    w.x = cvt_pk_bf16(bflo(p.x) + bflo(g.x) * v0[0], bfhi(p.x) + bfhi(g.x) * v0[1]);
                    w.y = cvt_pk_bf16(bflo(p.y) + bflo(g.y) * v0[2], bfhi(p.y) + bfhi(g.y) * v0[3]);
                    w.z = cvt_pk_bf16(bflo(p.z) + bflo(g.z) * v1[0], bfhi(p.z) + bfhi(g.z) * v1[1]);
                    w.w = cvt_pk_bf16(bflo(p.w) + bflo(g.w) * v1[2], bfhi(p.w) + bfhi(g.w) * v1[3]);
                    *(u32x4*)(Mg + ro + bj * HALF) = w; } }
    }
};
struct EpiResF32 {
    static constexpr bool PERM = false;
    const float* base; float* out; int ldc; float alpha;
    __device__ __forceinline__ void operator()(const f32x4 (&acc)[2][2][4][2], const Unit& u, int wr, int wc, int fr, int fq) const {
        const int row0 = u.pm * BM + wr * 64 + fr, col0 = u.pn * BM + wc * 32 + 4 * fq;
#pragma unroll
        for (int ai = 0; ai < 2; ++ai)
#pragma unroll
            for (int m = 0; m < 4; ++m) { const size_t ro = (size_t)(row0 + ai * HALF + m * 16) * ldc + col0;
#pragma unroll
                for (int bj = 0; bj < 2; ++bj)
#pragma unroll
                    for (int n = 0; n < 2; ++n) { const f32x4 bs = *(const f32x4*)(base + ro + bj * HALF + n * 16);
                        *(f32x4*)(out + ro + bj * HALF + n * 16) = bs * alpha + acc[ai][bj][m][n]; } }
    }
};

template <class Epi, class Sched, bool ALIGN_EPI = false>
__device__ __forceinline__ void gemm_phase(PG8_LAS unsigned char* lds, const Gemm g, const Sched& S, const Epi& E) {
    int tid_ = threadIdx.x; asm volatile("" : "+v"(tid_));
    const int tid = tid_, wid = __builtin_amdgcn_readfirstlane(tid >> 6), lane = tid & 63, wr = wid >> 2, wc = wid & 3, fr = lane & 15, fq = lane >> 4;
    const int K = g.K, nt = K / BK;
    unsigned voffA[2], voffB[2];
#pragma unroll
    for (int i = 0; i < 2; ++i) { int R, C; stage_rc(tid * 16 + i * 8192, R, C); const int Rb = Epi::PERM ? ((R & ~31) + perm32(R & 31)) : R;
        voffA[i] = (unsigned)(R * g.lda + C) * 2u; voffB[i] = (unsigned)(Rb * g.ldb + C) * 2u; }
    const size_t kstep = (size_t)(BK * 2);
    const size_t hstepA = (size_t)HALF * g.lda * 2, hstepB = (size_t)HALF * g.ldb * 2;
    const size_t tstepA = 2 * hstepA, tstepB = 2 * hstepB;
    const unsigned ldsw = (unsigned)wid * 1024u;
    const int aoff = lds_byte(wr * 64 + fr, fq * 8), boff = lds_byte(wc * 32 + fr, fq * 8);
#define PG8_SA(b, h) (((b) * 2 + (h)) * HTB)
#define PG8_SB(b, h) ((4 + (b) * 2 + (h)) * HTB)
#define PG8_STAGE(bufoff, gbase, voff) do { _Pragma("unroll") for (int _i = 0; _i < 2; ++_i) \
        __builtin_amdgcn_global_load_lds((const unsigned*)((const char*)(gbase) + (voff)[_i]), (PG8_LAS unsigned*)(lds + (bufoff) + ldsw + _i * 8192), 16, 0, 0); } while (0)
#define PG8_LDA(dst, b, h) do { _Pragma("unroll") for (int m = 0; m < 4; ++m) _Pragma("unroll") for (int k = 0; k < 2; ++k) dst[m][k] = *(const PG8_LAS bf16x8*)(lds + PG8_SA(b, h) + aoff + m * 2048 + k * 1024); } while (0)
#define PG8_LDB(dst, b, h) do { _Pragma("unroll") for (int n = 0; n < 2; ++n) _Pragma("unroll") for (int k = 0; k < 2; ++k) dst[n][k] = *(const PG8_LAS bf16x8*)(lds + PG8_SB(b, h) + boff + n * 2048 + k * 1024); } while (0)
#define PG8_MMA(ai, bj, At, Bt) do { __builtin_amdgcn_s_setprio(1); _Pragma("unroll") for (int m = 0; m < 4; ++m) _Pragma("unroll") for (int n = 0; n < 2; ++n) _Pragma("unroll") for (int k = 0; k < 2; ++k) \
        acc[ai][bj][m][n] = __builtin_amdgcn_mfma_f32_16x16x32_bf16(Bt[n][k], At[m][k], acc[ai][bj][m][n], 0, 0, 0); __builtin_amdgcn_s_setprio(0); } while (0)
#define PG8_WAIT_V(n) asm volatile("s_waitcnt vmcnt(" #n ")" ::: "memory")
#define PG8_WAIT_L(n) asm volatile("s_waitcnt lgkmcnt(" #n ")" ::: "memory")
#define PG8_BAR __builtin_amdgcn_s_barrier()
#define PG8_SCHED __builtin_amdgcn_sched_barrier(0)
    Unit cur, nxt; int ui = 0;
    if (!S.next(0, cur)) return;
    f32x4 acc[2][2][4][2];
#pragma unroll
    for (int a = 0; a < 2; ++a)
#pragma unroll
        for (int b = 0; b < 2; ++b)
#pragma unroll
            for (int m = 0; m < 4; ++m)
#pragma unroll
                for (int n = 0; n < 2; ++n) acc[a][b][m][n] = (f32x4){0.f, 0.f, 0.f, 0.f};
    bf16x8 At[4][2], B0[2][2], B1[2][2];
    const char* cA = (const char*)g.A + (size_t)cur.pm * tstepA; const char* cB = (const char*)g.Bt + (size_t)cur.pn * tstepB;
    S.a_ready(cur);
    PG8_STAGE(PG8_SB(0, 0), cB, voffB); PG8_STAGE(PG8_SB(0, 1), cB + hstepB, voffB); PG8_STAGE(PG8_SA(0, 0), cA, voffA); PG8_STAGE(PG8_SA(0, 1), cA + hstepA, voffA);
    if (wr == 1) PG8_BAR;
    PG8_WAIT_V(2); PG8_BAR;
    PG8_STAGE(PG8_SB(1, 0), cB + kstep, voffB); PG8_STAGE(PG8_SA(1, 0), cA + kstep, voffA); PG8_STAGE(PG8_SB(1, 1), cB + hstepB + kstep, voffB);
    PG8_WAIT_V(6); PG8_BAR;
    for (;;) {
        const bool has_next = S.next(ui + 1, nxt);
        const char* nA = has_next ? (const char*)g.A + (size_t)nxt.pm * tstepA : cA; const char* nB = has_next ? (const char*)g.Bt + (size_t)nxt.pn * tstepB : cB;
        for (int t = 0; t < nt; t += 2) {
            const bool last = (t == nt - 2);
            const char* a1 = cA + (size_t)(t + 1) * kstep;
            const char* a2 = last ? nA : cA + (size_t)(t + 2) * kstep; const char* b2 = last ? nB : cB + (size_t)(t + 2) * kstep;
            const char* a3 = a2 + kstep; const char* b3 = b2 + kstep;
            if (last && has_next) S.a_ready(nxt);
            PG8_LDB(B0, 0, 0); PG8_LDB(B1, 0, 1); PG8_SCHED; PG8_LDA(At, 0, 0); PG8_STAGE(PG8_SA(1, 1), a1 + hstepA, voffA);
            PG8_WAIT_V(8); PG8_WAIT_L(0); PG8_BAR; PG8_MMA(0, 0, At, B0); PG8_MMA(0, 1, At, B1); PG8_BAR; PG8_SCHED;
            PG8_LDA(At, 0, 1); PG8_STAGE(PG8_SB(0, 0), b2, voffB); PG8_STAGE(PG8_SB(0, 1), b2 + hstepB, voffB); PG8_STAGE(PG8_SA(0, 0), a2, voffA);
            PG8_WAIT_V(8); PG8_WAIT_L(0); PG8_BAR; PG8_MMA(1, 0, At, B0); PG8_MMA(1, 1, At, B1); PG8_BAR; PG8_SCHED;
            PG8_LDB(B0, 1, 0); PG8_LDB(B1, 1, 1); PG8_SCHED; PG8_LDA(At, 1, 0); PG8_STAGE(PG8_SA(0, 1), a2 + hstepA, voffA);
            PG8_WAIT_V(8); PG8_WAIT_L(0); PG8_BAR; PG8_MMA(0, 0, At, B0); PG8_MMA(0, 1, At, B1); PG8_BAR; PG8_SCHED;
            PG8_LDA(At, 1, 1); PG8_STAGE(PG8_SB(1, 0), b3, voffB); PG8_STAGE(PG8_SB(1, 1), b3 + hstepB, voffB); PG8_STAGE(PG8_SA(1, 0), a3, voffA);
            PG8_WAIT_V(8); PG8_WAIT_L(0); PG8_BAR; PG8_MMA(1, 0, At, B0); PG8_MMA(1, 1, At, B1); PG8_BAR; PG8_SCHED;
        }
        if constexpr (ALIGN_EPI) { if (wr == 0) PG8_BAR; }
        E(acc, cur, wr, wc, fr, fq); S.done(cur);
        if (!has_next) break;
#pragma unroll
        for (int a = 0; a < 2; ++a)
#pragma unroll
            for (int b = 0; b < 2; ++b)
#pragma unroll
                for (int m = 0; m < 4; ++m)
#pragma unroll
                    for (int n = 0; n < 2; ++n) acc[a][b][m][n] = (f32x4){0.f, 0.f, 0.f, 0.f};
        cur = nxt; cA = nA; cB = nB; ++ui;
        if constexpr (ALIGN_EPI) { if (wr == 1) PG8_BAR; }
    }
    PG8_WAIT_V(0);
    if constexpr (!ALIGN_EPI) { if (wr == 0) PG8_BAR; }
    PG8_BAR;
#undef PG8_SA
#undef PG8_SB
#undef PG8_STAGE
#undef PG8_LDA
#undef PG8_LDB
#undef PG8_MMA
#undef PG8_WAIT_V
#undef PG8_WAIT_L
#undef PG8_BAR
#undef PG8_SCHED
}
}

constexpr int NWAVES = 8;
constexpr int BATCH = 16, T = 2048, D = 1024, M = BATCH * T, FF = 4096, DEPTH = 2;
constexpr int IN_WIDTH = 8208;
constexpr int ZW = 5376;
constexpr int ZC_QA = 0, ZC_KA = 512, ZC_VA = 1024, ZC_QG = 1536, ZC_KG = 1792, ZC_VG = 2048, ZC_GO = 2560, ZC_QH = 3072, ZC_FH = 3584, ZC_IH = 4096, ZC_HO = 4608, ZC_GLR = 5120;
constexpr int ZC_MRG = 512;
constexpr int ZC_GATE = 3072;
constexpr int NWIN = ZW + 3 * D;
constexpr float LN_EPS = 1e-5f;
constexpr float ALPHA = 1.41421356237309515f;
constexpr int NPHASE = 1 + 8 * DEPTH;

constexpr size_t MiB = 1u << 20;
constexpr size_t WS_CTL = 0, CTL_ZERO_BYTES = 1 * MiB;
constexpr size_t WS_WIN = 1 * MiB;
constexpr size_t WS_WB = 34 * MiB;
constexpr size_t WS_WOUT = 40 * MiB;
constexpr size_t WS_WUP = 44 * MiB;
constexpr size_t WS_WDN = 60 * MiB;
constexpr size_t WS_XB = 76 * MiB;
constexpr size_t WS_Z = 140 * MiB;
constexpr size_t WS_END = 476 * MiB;
static_assert(WS_WIN + (size_t)DEPTH * NWIN * D * 2 <= WS_WB && WS_Z + (size_t)M * ZW * 2 <= WS_END, "d_ws map");
constexpr int CW_BAR = 4096;
constexpr int CW_QUEUE = 16384;

constexpr int RING_BYTES = 147456;
constexpr int LDSCTL_OFF = RING_BYTES, MISC_OFF = LDSCTL_OFF + 320;
constexpr int LDS_BYTES = RING_BYTES + 1024;

#define GAS __attribute__((address_space(1)))
#define LAS __attribute__((address_space(3)))
typedef unsigned short bf16;
typedef unsigned v4u __attribute__((ext_vector_type(4)));
typedef unsigned v2u __attribute__((ext_vector_type(2)));
typedef float f32x4 __attribute__((ext_vector_type(4)));
typedef GAS unsigned gu32;
#define RLX_AGENT __ATOMIC_RELAXED, __HIP_MEMORY_SCOPE_AGENT
#define LDS_WAIT() asm volatile("s_waitcnt lgkmcnt(0)" ::: "memory")
#define VM_WAIT() asm volatile("s_waitcnt vmcnt(0)" ::: "memory")
__device__ __forceinline__ unsigned f2bf(float f) { unsigned u = __builtin_bit_cast(unsigned, f); return (u + 0x7fffu + ((u >> 16) & 1u)) >> 16; }
__device__ __forceinline__ unsigned pk2(float lo, float hi) { return f2bf(lo) | (f2bf(hi) << 16); }
__device__ __forceinline__ float bf2f(unsigned short b) { return __uint_as_float((unsigned)b << 16); }
__device__ __forceinline__ float wave_sum(float v) {
#pragma unroll
    for (int o = 1; o < 64; o <<= 1) v += __shfl_xor(v, o);
    return v;
}
__device__ __forceinline__ float wave_max(float v) {
#pragma unroll
    for (int o = 1; o < 64; o <<= 1) v = fmaxf(v, __shfl_xor(v, o));
    return v;
}
__device__ __forceinline__ float logsigmoidf(float x) { return fminf(x, 0.f) - log1pf(expf(-fabsf(x))); }

#define XB_TMO      128
#define XB_XCNT(j)  (256  + 64 * (j))
#define XB_XSUB(j)  (1280 + 64 * (j))
#define XB_XGEN(j)  (2304 + 64 * (j))
#define XB_TOP      3328
#define XB_TOPGEN   3392
#define XCD_BAR_WORDS 3456
#define XB_SPIN_CAP (1u << 18)

__device__ __forceinline__ unsigned xb_ld(unsigned* p)              { return __hip_atomic_load(p, __ATOMIC_RELAXED, __HIP_MEMORY_SCOPE_AGENT); }
__device__ __forceinline__ unsigned xb_add(unsigned* p, unsigned v) { return __hip_atomic_fetch_add(p, v, __ATOMIC_RELAXED, __HIP_MEMORY_SCOPE_AGENT); }
__device__ __forceinline__ unsigned xb_xcc_id() { return (unsigned)__builtin_amdgcn_s_getreg((3 << 11) | 20) & 0xFu; }
#define XB_SPIN(cond, bar) do { unsigned _sp = 0; while (cond) { __builtin_amdgcn_s_sleep(1); \
    if ((++_sp & 255u) == 0u) { if (xb_ld(&(bar)[XB_TMO])) break; if (_sp > XB_SPIN_CAP) { atomicAdd(&(bar)[XB_TMO], 1u); break; } } } } while (0)

struct XcdBarrier {
    unsigned* bar; unsigned x;
    volatile LAS unsigned* st;
};
__device__ __forceinline__ XcdBarrier xcd_barrier_post(unsigned* bar, volatile LAS unsigned* st) {
    XcdBarrier b; b.bar = bar; b.x = xb_xcc_id(); b.st = st;
    if (threadIdx.x == 0) (void)xb_add(&bar[XB_XCNT(b.x)], 1u);
    return b;
}
__device__ __forceinline__ void xcd_barrier_complete(unsigned* bar, unsigned x, unsigned& nloc, unsigned& nx) {
    const unsigned G = gridDim.x * gridDim.y * gridDim.z;
    unsigned sum, cnt, mine, sp = 0u;
    for (;;) {
        sum = 0u; cnt = 0u; mine = 0u;
#pragma unroll
        for (unsigned j = 0; j < 16; ++j) { const unsigned c = xb_ld(&bar[XB_XCNT(j)]); sum += c; cnt += (c > 0u) ? 1u : 0u; mine = (j == x) ? c : mine; }
        if (sum == G) break;
        __builtin_amdgcn_s_sleep(1);
        if ((++sp & 255u) == 0u) { if (xb_ld(&bar[XB_TMO])) break; if (sp > XB_SPIN_CAP) { atomicAdd(&bar[XB_TMO], 1u); break; } }
    }
    nloc = mine > 0u ? mine : 1u; nx = cnt > 0u ? cnt : 1u;
}
__device__ __forceinline__ void xcd_barrier(const XcdBarrier& b) {
    asm volatile("s_waitcnt vmcnt(0)" ::: "memory");
    __syncthreads();
    if (threadIdx.x == 0) {
        unsigned* bar = b.bar;
        __builtin_amdgcn_s_waitcnt(0);
        unsigned nloc = b.st[0], nx = b.st[1];
        if (nloc == 0u) { xcd_barrier_complete(bar, b.x, nloc, nx); b.st[0] = nloc; b.st[1] = nx; }
        const unsigned old = xb_add(&bar[XB_XSUB(b.x)], 1u);
        const unsigned gen = old / nloc;
        if (old + 1u == (gen + 1u) * nloc) {
            __builtin_amdgcn_fence(__ATOMIC_RELEASE, "agent");
            asm volatile("s_waitcnt vmcnt(0)" ::: "memory");
            const unsigned og = xb_add(&bar[XB_TOP], 1u);
            const unsigned tg = og / nx;
            if (og + 1u == (tg + 1u) * nx) xb_add(&bar[XB_TOPGEN], 1u);
            else XB_SPIN(xb_ld(&bar[XB_TOPGEN]) == tg, bar);
            __builtin_amdgcn_fence(__ATOMIC_ACQUIRE, "agent");
            xb_add(&bar[XB_XGEN(b.x)], 1u);
            asm volatile("s_waitcnt vmcnt(0)" ::: "memory");
        } else {
            XB_SPIN(xb_ld(&bar[XB_XGEN(b.x)]) == gen, bar);
            __builtin_amdgcn_fence(__ATOMIC_ACQUIRE, "agent");
            asm volatile("s_waitcnt vmcnt(0)" ::: "memory");
        }
    }
    __syncthreads();
}

struct Frame {
    LAS unsigned char* lds;
    volatile LAS unsigned* MISC;
    gu32* ctl;
    int vcu, G;
};
#define PHASE_IDS() int tid_o_ = threadIdx.x; asm volatile("" : "+v"(tid_o_)); const int tid = tid_o_, lane = tid & 63, wave = __builtin_amdgcn_readfirstlane(tid >> 6); (void)tid; (void)lane; (void)wave

__device__ __forceinline__ int win_src_col(int j) {
    if (j < 2560) return j;
    if (j < 5120) return j + 16;
    if (j < 5136) return j - 5120 + 2560;
    if (j < ZW) return -1;
    return j - ZW + 5136;
}
template <bool MAPWIN>
__device__ __forceinline__ void p0_transpose_item(const float* W, int K, int Nsrc, int Ndst, bf16* WT, LAS float* scr, int item, int lane) {
    const int nblk = Ndst / 32, kb = item / nblk, nb = item % nblk, k0 = 64 * kb, n0 = 32 * nb;
    const int nd = n0 + (lane & 31); const int sc = MAPWIN ? win_src_col(nd) : nd;
#pragma unroll 8
    for (int i = 0; i < 32; ++i) { const int kk = 2 * i + (lane >> 5); scr[kk * 33 + (lane & 31)] = (sc >= 0) ? W[(size_t)(k0 + kk) * Nsrc + sc] : 0.f; }
    LDS_WAIT(); asm volatile("" ::: "memory");
    const int c = lane & 7;
#pragma unroll
    for (int j = 0; j < 4; ++j) { const int n = (lane >> 3) + 8 * j; const LAS float* s = scr + (8 * c) * 33 + n;
        v4u o; o.x = pk2(s[0 * 33], s[1 * 33]); o.y = pk2(s[2 * 33], s[3 * 33]); o.z = pk2(s[4 * 33], s[5 * 33]); o.w = pk2(s[6 * 33], s[7 * 33]);
        *(GAS v4u*)(WT + (size_t)(n0 + n) * K + k0 + 8 * c) = o; }
    LDS_WAIT(); asm volatile("" ::: "memory");
}

struct Args { const float* in[17]; float* out; unsigned char* ws; int ph_lo, ph_hi; };

__device__ __forceinline__ void p0_prologue(Frame& F, const Args& a) {
    PHASE_IDS();
    LAS float* scr = (LAS float*)(F.lds + wave * 16384);
    const int gw = F.vcu * NWAVES + wave, NGW = F.G * NWAVES;
    constexpr int I_IN = (D / 64) * (NWIN / 32), I_BR = (512 / 64) * (D / 32), I_OUT = (D / 64) * (D / 32), I_UP = (D / 64) * (FF / 32), I_DN = (FF / 64) * (D / 32);
    constexpr int PER_LAYER = I_IN + 3 * I_BR + I_OUT + I_UP + I_DN;
    for (int it = gw; it < DEPTH * PER_LAYER; it += NGW) {
        const int l = it / PER_LAYER; int r = it % PER_LAYER;
        if (r < I_IN) { p0_transpose_item<true>(a.in[1] + (size_t)l * D * IN_WIDTH, D, IN_WIDTH, NWIN, (bf16*)(a.ws + WS_WIN) + (size_t)l * NWIN * D, scr, r, lane); continue; } r -= I_IN;
        if (r < 3 * I_BR) { const int n = r / I_BR; p0_transpose_item<false>(a.in[9] + (size_t)(l * 3 + n) * 512 * D, 512, D, D, (bf16*)(a.ws + WS_WB) + (size_t)(l * 3 + n) * D * 512, scr, r % I_BR, lane); continue; } r -= 3 * I_BR;
        if (r < I_OUT) { p0_transpose_item<false>(a.in[10] + (size_t)l * D * D, D, D, D, (bf16*)(a.ws + WS_WOUT) + (size_t)l * D * D, scr, r, lane); continue; } r -= I_OUT;
        if (r < I_UP) { p0_transpose_item<false>(a.in[13] + (size_t)l * D * FF, D, FF, FF, (bf16*)(a.ws + WS_WUP) + (size_t)l * FF * D, scr, r, lane); continue; } r -= I_UP;
        p0_transpose_item<false>(a.in[14] + (size_t)l * FF * D, FF, D, D, (bf16*)(a.ws + WS_WDN) + (size_t)l * D * FF, scr, r, lane);
    }
    const float* x = a.in[0]; bf16* XB = (bf16*)(a.ws + WS_XB);
    for (int m = gw; m < M; m += NGW) {
        const GAS f32x4* xr = (const GAS f32x4*)(x + (size_t)m * D) + lane;
        GAS unsigned long long* o8 = (GAS unsigned long long*)(XB + (size_t)m * D) + lane;
#pragma unroll
        for (int j = 0; j < 4; ++j) { const f32x4 v = xr[64 * j]; o8[64 * j] = (unsigned long long)pk2(v.x, v.y) | ((unsigned long long)pk2(v.z, v.w) << 32); }
    }
}

__device__ __forceinline__ void ln_phase(Frame& F, float* R, bf16* XB, const float* w, const float* b) {
    PHASE_IDS();
    const int gw = F.vcu * NWAVES + wave, NGW = F.G * NWAVES;
    f32x4 wv[4], bv[4];
#pragma unroll
    for (int j = 0; j < 4; ++j) { wv[j] = ((const f32x4*)w)[lane + 64 * j]; bv[j] = ((const f32x4*)b)[lane + 64 * j]; }
    for (int m = gw; m < M; m += NGW) {
        GAS f32x4* xr = (GAS f32x4*)(R + (size_t)m * D) + lane;
        f32x4 v[4]; float s = 0.f;
#pragma unroll
        for (int j = 0; j < 4; ++j) { v[j] = xr[64 * j]; s += (v[j].x + v[j].y) + (v[j].z + v[j].w); }
        const float mean = wave_sum(s) * (1.f / D); float s2 = 0.f;
#pragma unroll
        for (int j = 0; j < 4; ++j) { v[j] = v[j] - mean; s2 += (v[j].x * v[j].x + v[j].y * v[j].y) + (v[j].z * v[j].z + v[j].w * v[j].w); }
        const float rstd = 1.f / sqrtf(wave_sum(s2) * (1.f / D) + LN_EPS);
        GAS unsigned long long* o8 = (GAS unsigned long long*)(XB + (size_t)m * D) + lane;
#pragma unroll
        for (int j = 0; j < 4; ++j) { const f32x4 y = v[j] * rstd * wv[j] + bv[j]; xr[64 * j] = y;
            o8[64 * j] = (unsigned long long)pk2(y.x, y.y) | ((unsigned long long)pk2(y.z, y.w) << 32); }
    }
}

__device__ __forceinline__ void attn_naive_item(Frame& F, bf16* Z, int b, int h, int rb, float lam, float post, const float* normw) {
    PHASE_IDS();
    LAS float* sb1 = (LAS float*)(F.lds + wave * 16384);
    LAS float* sb2 = sb1 + 2048;
    LAS float* qb = (LAS float*)(F.lds + 131072 + wave * 512);
    const float slope = exp2f(-2.0f * (float)(h + 1));
    const bf16* zb = Z + (size_t)b * T * ZW;
    for (int rr = 0; rr < 8; ++rr) {
        const int i = rb * 64 + wave * 8 + rr;
        const bf16* qrow = zb + (size_t)i * ZW + ZC_QA + h * 128;
        qb[lane] = bf2f(qrow[lane]) * 0.125f; qb[64 + lane] = bf2f(qrow[64 + lane]) * 0.125f;
        LDS_WAIT();
        float m1 = -1e30f, m2 = -1e30f;
        for (int j0 = 0; j0 <= i; j0 += 64) {
            const int j = j0 + lane;
            if (j <= i) {
                const bf16* krow = zb + (size_t)j * ZW + ZC_KA + h * 128;
                float d1 = 0.f, d2 = 0.f;
#pragma unroll
                for (int c = 0; c < 8; ++c) {
                    const v4u k1 = *(const v4u*)(krow + c * 8), k2 = *(const v4u*)(krow + 64 + c * 8);
                    const f32x4 qa = *(const LAS f32x4*)(qb + c * 8), qc = *(const LAS f32x4*)(qb + c * 8 + 4);
                    const f32x4 qd = *(const LAS f32x4*)(qb + 64 + c * 8), qe = *(const LAS f32x4*)(qb + 64 + c * 8 + 4);
                    d1 += qa.x * pg8::bflo(k1.x) + qa.y * pg8::bfhi(k1.x) + qa.z * pg8::bflo(k1.y) + qa.w * pg8::bfhi(k1.y)
                        + qc.x * pg8::bflo(k1.z) + qc.y * pg8::bfhi(k1.z) + qc.z * pg8::bflo(k1.w) + qc.w * pg8::bfhi(k1.w);
                    d2 += qd.x * pg8::bflo(k2.x) + qd.y * pg8::bfhi(k2.x) + qd.z * pg8::bflo(k2.y) + qd.w * pg8::bfhi(k2.y)
                        + qe.x * pg8::bflo(k2.z) + qe.y * pg8::bfhi(k2.z) + qe.z * pg8::bflo(k2.w) + qe.w * pg8::bfhi(k2.w);
                }
                const float bias = slope * (float)(i - j);
                const float s1 = d1 - bias, s2 = d2 - bias;
                sb1[j] = s1; sb2[j] = s2; m1 = fmaxf(m1, s1); m2 = fmaxf(m2, s2);
            }
        }
        m1 = wave_max(m1); m2 = wave_max(m2);
        float l1 = 0.f, l2 = 0.f;
        for (int j0 = 0; j0 <= i; j0 += 64) { const int j = j0 + lane;
            if (j <= i) { const float e1 = expf(sb1[j] - m1), e2 = expf(sb2[j] - m2); sb1[j] = e1; sb2[j] = e2; l1 += e1; l2 += e2; } }
        l1 = wave_sum(l1); l2 = wave_sum(l2);
        const float r1 = 1.0f / l1, r2 = lam / l2;
        for (int j0 = 0; j0 <= i; j0 += 64) { const int j = j0 + lane; if (j <= i) sb1[j] = sb1[j] * r1 - sb2[j] * r2; }
        LDS_WAIT();
        float a0 = 0.f, a1 = 0.f;
        const bf16* vcol = zb + ZC_VA + h * 128 + 2 * lane;
#pragma unroll 4
        for (int j = 0; j <= i; ++j) { const float a = sb1[j]; const unsigned vv = *(const unsigned*)(vcol + (size_t)j * ZW); a0 += a * pg8::bflo(vv); a1 += a * pg8::bfhi(vv); }
        const float ss = wave_sum(a0 * a0 + a1 * a1) * (1.0f / 128.0f);
        const float r = post / sqrtf(ss + LN_EPS);
        const float o0 = a0 * r * normw[2 * lane], o1 = a1 * r * normw[2 * lane + 1];
        *(GAS unsigned*)((bf16*)zb + (size_t)i * ZW + ZC_QA + h * 128 + 2 * lane) = pk2(o0, o1);
        LDS_WAIT();
    }
}

template <int MIXER>
__device__ __forceinline__ void chain_naive_unit(Frame& F, bf16* Z, int b, int h, int l, const Args& a) {
    constexpr int DK = MIXER == 0 ? 64 : 128, DKS = DK / 4, CH = 32;
    constexpr int ZQ = MIXER == 0 ? ZC_QG : ZC_QH, ZK = MIXER == 0 ? ZC_KG : ZC_FH, ZV = MIXER == 0 ? ZC_VG : ZC_IH, ZG = MIXER == 0 ? ZC_GO : ZC_HO;
    LAS float* ge = (LAS float*)F.lds;
    LAS float* qs = ge + CH * DK;
    LAS float* ks = qs + CH * DK;
    LAS float* vs = (LAS float*)(F.lds + 49152);
    LAS float* op = (LAS float*)(F.lds + 65536);
    PHASE_IDS();
    const int col = tid & 127, sl = tid >> 7;
    bf16* zb = Z + (size_t)b * T * ZW;
    const float* normw = (MIXER == 0 ? a.in[6] : a.in[7]) + l * 128;
    const float* Wg = a.in[2] + (size_t)l * 16 * 256; const float* bg = a.in[3] + l * 256;
    const float* lbp = a.in[8];
    float S[DKS];
#pragma unroll
    for (int d = 0; d < DKS; ++d) S[d] = 0.f;
    for (int c0 = 0; c0 < T; c0 += CH) {
        for (int idx = tid; idx < CH * DK; idx += 512) {
            const int t = idx / DK, d = idx % DK; const bf16* zr = zb + (size_t)(c0 + t) * ZW;
            float lg, kv, qv;
            if (MIXER == 0) {
                float pre = bg[h * 64 + d];
#pragma unroll
                for (int r = 0; r < 16; ++r) pre += bf2f(zr[ZC_GLR + r]) * Wg[r * 256 + h * 64 + d];
                lg = logsigmoidf(pre) * (1.0f / 16.0f); kv = bf2f(zr[ZK + h * DK + d]); qv = bf2f(zr[ZQ + h * DK + d]) * 0.125f;
            } else {
                const int c = h * 128 + d; const float x0 = lbp[c], x1 = lbp[512 + c], mx = fmaxf(x0, x1), e0 = expf(x0 - mx), e1 = expf(x1 - mx);
                const float lb = (l == 0) ? 0.f : e1 / (e0 + e1);
                const float aa = logf(fmaxf(lb, 1e-30f)), bb = log1pf(-lb) + logsigmoidf(bf2f(zr[ZK + c]));
                lg = fmaxf(aa, bb) + log1pf(expf(-fabsf(aa - bb))); kv = -expm1f(lg); qv = bf2f(zr[ZQ + c]);
            }
            ge[idx] = expf(lg); ks[idx] = kv; qs[idx] = qv;
        }
        for (int idx = tid; idx < CH * 128; idx += 512) { const int t = idx >> 7, c = idx & 127; vs[idx] = bf2f(zb[(size_t)(c0 + t) * ZW + ZV + h * 128 + c]); }
        __syncthreads();
        for (int t = 0; t < CH; ++t) {
            const float v = vs[t * 128 + col]; float o = 0.f;
#pragma unroll
            for (int d4 = 0; d4 < DKS; d4 += 4) {
                const f32x4 g4 = *(const LAS f32x4*)(ge + t * DK + sl * DKS + d4), k4 = *(const LAS f32x4*)(ks + t * DK + sl * DKS + d4), q4 = *(const LAS f32x4*)(qs + t * DK + sl * DKS + d4);
                S[d4 + 0] = g4.x * S[d4 + 0] + k4.x * v; o += q4.x * S[d4 + 0];
                S[d4 + 1] = g4.y * S[d4 + 1] + k4.y * v; o += q4.y * S[d4 + 1];
                S[d4 + 2] = g4.z * S[d4 + 2] + k4.z * v; o += q4.z * S[d4 + 2];
                S[d4 + 3] = g4.w * S[d4 + 3] + k4.w * v; o += q4.w * S[d4 + 3];
            }
            op[(sl * CH + t) * 128 + col] = o;
        }
        __syncthreads();
#pragma unroll
        for (int tt = 0; tt < 4; ++tt) {
            const int t = wave * 4 + tt, c = 2 * lane;
            float o0 = 0.f, o1 = 0.f;
#pragma unroll
            for (int s = 0; s < 4; ++s) { o0 += op[(s * CH + t) * 128 + c]; o1 += op[(s * CH + t) * 128 + c + 1]; }
            const float ss = wave_sum(o0 * o0 + o1 * o1) * (1.0f / 128.0f), r = 1.0f / sqrtf(ss + LN_EPS);
            bf16* zr = zb + (size_t)(c0 + t) * ZW;
            const unsigned gw2 = *(const unsigned*)(zr + ZG + h * 128 + c);
            const float g0 = pg8::bflo(gw2), g1 = pg8::bfhi(gw2);
            const float y0 = o0 * r * normw[c] * (g0 / (1.0f + expf(-g0))), y1 = o1 * r * normw[c + 1] * (g1 / (1.0f + expf(-g1)));
            *(GAS unsigned*)(zr + ZV + h * 128 + c) = pk2(y0, y1);
        }
        __syncthreads();
    }
}

namespace att {
typedef short bf16x8 __attribute__((ext_vector_type(8)));
typedef short s16x4 __attribute__((ext_vector_type(4)));
typedef short v4i16_t __attribute__((ext_vector_type(4)));
typedef float f32x16 __attribute__((ext_vector_type(16)));
typedef unsigned u32x4 __attribute__((ext_vector_type(4)));
constexpr float QSCALE = 0.125f * 1.4426950408889634f;
constexpr int SLOT = 32768, OFF_V = 16384, OFF_Q = 65536, OFF_WS = 131072;
__device__ __forceinline__ int crow(int r, int hi) { return (r & 3) + 8 * (r >> 2) + 4 * hi; }
__device__ __forceinline__ void glds16(const void* gsrc, unsigned lds_dst) { unsigned keep;
    asm volatile("s_mov_b32 %0, m0\n\ts_mov_b32 m0, %2\n\ts_nop 0\n\tglobal_load_lds_dwordx4 %1, off\n\ts_mov_b32 m0, %0" : "=&s"(keep) : "v"(gsrc), "s"(lds_dst) : "memory"); }
typedef float f32x2_t __attribute__((ext_vector_type(2))); typedef __bf16 bf16x2_t __attribute__((ext_vector_type(2)));
__device__ __forceinline__ unsigned cvtpk(float lo, float hi) { f32x2_t v = {lo, hi}; bf16x2_t b = __builtin_convertvector(v, bf16x2_t); return __builtin_bit_cast(unsigned, b); }
__device__ __forceinline__ s16x4 vtr(const LAS unsigned char* p) { return __builtin_bit_cast(s16x4, __builtin_amdgcn_ds_read_tr16_b64_v4i16((LAS v4i16_t*)p)); }
#define ATT_WAIT_BAR() asm volatile("s_waitcnt vmcnt(0) lgkmcnt(0)\n\ts_barrier" ::: "memory")

template <int THRL>
__device__ __forceinline__ void attn_unit(bf16* Z, int b, int h, int qb, float lam, float post, const float* normw, LAS unsigned char* lds) {
    PHASE_IDS();
    const int r32 = lane & 31, hi = lane >> 5;
    bf16* zb = Z + (size_t)b * T * ZW;
    const int q0 = qb * 256;
    const unsigned lds0 = (unsigned)(unsigned long)lds;
    const float sl2 = exp2f(-2.0f * (float)(h + 1)) * 1.4426950408889634f;
    const bf16* ksrc = zb + (size_t)lane * ZW + ZC_KA + h * 128 + (2 * wave) * 8;
    const bf16* vsrc = zb + (size_t)(16 * ((2 * wave) & 3) + (lane >> 2)) * ZW + ZC_VA + h * 128 + (wave >> 1) * 32 + (lane & 3) * 8;
    const unsigned kdst = lds0 + (2 * wave) * 1024, vdst = lds0 + OFF_V + (2 * wave) * 1024;
#define ATT_DMA(t, slot) do { const size_t to_ = (size_t)(t) * 64 * ZW; const unsigned so_ = (unsigned)(slot) * SLOT; \
        glds16(ksrc + to_, (unsigned)__builtin_amdgcn_readfirstlane(kdst + so_)); glds16(ksrc + to_ + 8, (unsigned)__builtin_amdgcn_readfirstlane(kdst + so_ + 1024)); \
        glds16(vsrc + to_, (unsigned)__builtin_amdgcn_readfirstlane(vdst + so_)); glds16(vsrc + to_ + (size_t)16 * ZW, (unsigned)__builtin_amdgcn_readfirstlane(vdst + so_ + 1024)); } while (0)
    { const bf16* qsrc = zb + (size_t)(q0 + 32 * wave + r32) * ZW + ZC_QA + h * 128 + hi * 8;
#pragma unroll
      for (int i = 0; i < 8; ++i) glds16(qsrc + 16 * i, (unsigned)__builtin_amdgcn_readfirstlane(lds0 + OFF_Q + wave * 8192 + i * 1024)); }
    ATT_DMA(0, 0);
    const LAS unsigned char* Qw = lds + OFF_Q + wave * 8192 + r32 * 16 + hi * 512;
    LAS float* wsf = (LAS float*)(lds + OFF_WS + wave * 256);
    const int vlane = (4 * hi + ((lane & 15) >> 2)) * 64 + ((lane >> 4) & 1) * 32 + (lane & 3) * 8;
    f32x16 o1[4], o2[4];
#pragma unroll
    for (int d = 0; d < 4; ++d) { o1[d] = f32x16{}; o2[d] = f32x16{}; }
    float mh1 = 0.f, mh2 = 0.f, l1 = 0.f, l2 = 0.f;
    const int NT = 4 * (qb + 1);
    const int qrel = 32 * wave + r32;
    for (int t = 0; t < NT; ++t) {
        ATT_WAIT_BAR();
        if (t + 1 < NT) ATT_DMA(t + 1, (t + 1) & 1);
        const int jb = t - (NT - 4);
        if (jb >= 0 && 64 * jb > 32 * wave + 31) continue;
        int hi_ = hi, qrel_ = qrel; asm volatile("" : "+v"(hi_), "+v"(qrel_));
        const LAS unsigned char* Ks = lds + (t & 1) * SLOT + r32 * 16 + hi * 1024;
        const LAS unsigned char* Vs = lds + (t & 1) * SLOT + OFF_V + vlane;
#define ATT_STEP(MI, KB, MH, LL, OO) do { \
        f32x16 sa; \
        { const float base0 = sl2 * (float)(64 * t + 32 * KB + 4 * hi_) - MH; \
          _Pragma("unroll") for (int r = 0; r < 16; ++r) sa[r] = base0 + sl2 * (float)((r & 3) + 8 * (r >> 2)); \
          if (jb >= 0) { _Pragma("unroll") for (int r = 0; r < 16; ++r) { if (64 * jb + 32 * KB + crow(r, hi_) > qrel_) sa[r] = -INFINITY; } } } \
        _Pragma("unroll") for (int d0 = 0; d0 < 4; ++d0) { \
            const bf16x8 qf = *(const LAS bf16x8*)(Qw + (8 * MI + 2 * d0) * 512); \
            const bf16x8 ka = *(const LAS bf16x8*)(Ks + (8 * MI + 2 * d0) * 1024 + KB * 512); \
            sa = __builtin_amdgcn_mfma_f32_32x32x16_bf16(ka, qf, sa, 0, 0, 0); } \
        float rm; \
        { float a = fmaxf(sa[0], sa[1]); \
          _Pragma("unroll") for (int r = 2; r < 16; ++r) a = fmaxf(a, sa[r]); \
          auto rr = __builtin_amdgcn_permlane32_swap(__float_as_uint(a), __float_as_uint(a), false, false); \
          rm = fmaxf(__uint_as_float(rr[0]), __uint_as_float(rr[1])); } \
        const bool first_ = (t == 0 && KB == 0); \
        if (first_ || __any(rm > (float)THRL)) { \
            const float dl = first_ ? rm : fmaxf(rm, 0.f); \
            MH += dl; \
            _Pragma("unroll") for (int r = 0; r < 16; ++r) sa[r] -= dl; \
            if (!first_) { \
                const float f = __builtin_amdgcn_exp2f(-dl); LL *= f; \
                if (hi == 0) wsf[r32] = f; \
                LDS_WAIT(); \
                _Pragma("unroll") for (int r = 0; r < 16; ++r) { const float fr_ = wsf[crow(r, hi)]; \
                    _Pragma("unroll") for (int d = 0; d < 4; ++d) OO[d][r] *= fr_; } \
                LDS_WAIT(); \
            } } \
        u32x4 pa, pb; \
        { float s_ = 0.f; \
          _Pragma("unroll") for (int r = 0; r < 16; ++r) { sa[r] = __builtin_amdgcn_exp2f(sa[r]); s_ += sa[r]; } \
          LL += s_; \
          _Pragma("unroll") for (int i = 0; i < 4; ++i) { pa[i] = cvtpk(sa[2 * i], sa[2 * i + 1]); pb[i] = cvtpk(sa[8 + 2 * i], sa[9 + 2 * i]); } } \
        __builtin_amdgcn_sched_barrier(0); \
        _Pragma("unroll") for (int d0 = 0; d0 < 4; ++d0) { \
            const s16x4 lo0 = vtr(Vs + (d0 * 4 + 2 * KB) * 1024), hh0 = vtr(Vs + (d0 * 4 + 2 * KB) * 1024 + 512); \
            const s16x4 lo1 = vtr(Vs + (d0 * 4 + 2 * KB + 1) * 1024), hh1 = vtr(Vs + (d0 * 4 + 2 * KB + 1) * 1024 + 512); \
            OO[d0] = __builtin_amdgcn_mfma_f32_32x32x16_bf16(__builtin_bit_cast(bf16x8, pa), ((bf16x8){lo0[0], lo0[1], lo0[2], lo0[3], hh0[0], hh0[1], hh0[2], hh0[3]}), OO[d0], 0, 0, 0); \
            OO[d0] = __builtin_amdgcn_mfma_f32_32x32x16_bf16(__builtin_bit_cast(bf16x8, pb), ((bf16x8){lo1[0], lo1[1], lo1[2], lo1[3], hh1[0], hh1[1], hh1[2], hh1[3]}), OO[d0], 0, 0, 0); } \
        __builtin_amdgcn_sched_barrier(0); \
    } while (0)
        ATT_STEP(0, 0, mh1, l1, o1);
        ATT_STEP(1, 0, mh2, l2, o2);
        if (jb < 0 || 64 * jb + 32 <= 32 * wave + 31) {
            ATT_STEP(0, 1, mh1, l1, o1);
            ATT_STEP(1, 1, mh2, l2, o2);
        }
    }
    { auto rr = __builtin_amdgcn_permlane32_swap(__float_as_uint(l1), __float_as_uint(l1), false, false); l1 = __uint_as_float(rr[0]) + __uint_as_float(rr[1]); }
    { auto rr = __builtin_amdgcn_permlane32_swap(__float_as_uint(l2), __float_as_uint(l2), false, false); l2 = __uint_as_float(rr[0]) + __uint_as_float(rr[1]); }
    if (hi == 0) { wsf[r32] = 1.0f / l1; wsf[32 + r32] = lam / l2; }
    LDS_WAIT();
    float nw[4];
#pragma unroll
    for (int d = 0; d < 4; ++d) nw[d] = normw[d * 32 + r32] * post;
    ATT_WAIT_BAR();
    LAS bf16* stg = (LAS bf16*)(lds + OFF_Q + wave * 8192);
#pragma unroll
    for (int r = 0; r < 16; ++r) {
        const int orow = crow(r, hi); const float f1 = wsf[orow], f2 = wsf[32 + orow];
        float v[4], ss = 0.f;
#pragma unroll
        for (int d = 0; d < 4; ++d) { v[d] = o1[d][r] * f1 - o2[d][r] * f2; ss += v[d] * v[d]; }
#pragma unroll
        for (int o = 1; o < 32; o <<= 1) ss += __shfl_xor(ss, o);
        const float sc = 1.0f / sqrtf(ss * (1.0f / 128.0f) + LN_EPS);
#pragma unroll
        for (int d = 0; d < 4; ++d) stg[orow * 128 + d * 32 + r32] = (bf16)f2bf(v[d] * sc * nw[d]);
    }
    LDS_WAIT();
    bf16* orow0 = zb + (size_t)(q0 + 32 * wave) * ZW + ZC_QA + h * 128;
#pragma unroll
    for (int i = 0; i < 8; ++i) { const int row = i * 4 + (lane >> 4), ch = lane & 15; const u32x4 v = *(const LAS u32x4*)(stg + row * 128 + ch * 8); *(GAS u32x4*)(orow0 + (size_t)row * ZW + ch * 8) = v; }
    ATT_WAIT_BAR();
#undef ATT_DMA
#undef ATT_STEP
}
}

__global__ void __launch_bounds__(NWAVES * 64, 2) skel_fwd(Args args) {
    extern __shared__ __attribute__((aligned(16))) unsigned char lds[];
    Frame F;
    F.lds = (LAS unsigned char*)lds;
    F.MISC = (volatile LAS unsigned*)(F.lds + MISC_OFF);
    F.G = gridDim.x; { const int bx = blockIdx.x; F.vcu = (F.G % 8 == 0) ? (bx % 8) * (F.G / 8) + bx / 8 : bx; }
    unsigned char* ws = args.ws;
    F.ctl = (gu32*)(ws + WS_CTL);
    for (int u = threadIdx.x; u < (LDS_BYTES - LDSCTL_OFF) / 4; u += NWAVES * 64) ((LAS unsigned*)(F.lds + LDSCTL_OFF))[u] = 0u;
    __syncthreads();
    XcdBarrier bar; bar.bar = (unsigned*)(F.ctl + CW_BAR); bar.x = 0; bar.st = nullptr;
    if (MK_N_LAUNCHES == 1) bar = xcd_barrier_post((unsigned*)(F.ctl + CW_BAR), F.MISC + 8);
#define GRID_BAR() do { if (MK_N_LAUNCHES == 1) xcd_barrier(bar); } while (0)
    const int lo = args.ph_lo, hi = args.ph_hi;
#define PHON(j) (((MK_PHASE_MASK) >> (j)) & 1)
#define IN(k) (lo <= (k) && (k) < hi)
#define BOTH(k) (IN(k) && IN((k) + 1))

    bf16* const XB = (bf16*)(ws + WS_XB);
    bf16* const Z = (bf16*)(ws + WS_Z);
    bf16* const H = (bf16*)(ws + WS_Z);
    float* const R = args.out;

    if (PHON(0) && IN(0)) { p0_prologue(F, args); if (BOTH(0)) GRID_BAR(); }

    for (int l = 0; l < DEPTH; ++l) {
        const int pb = 1 + 8 * l;
        const bf16* WinT = (const bf16*)(ws + WS_WIN) + (size_t)l * NWIN * D;
        const bf16* WbT = (const bf16*)(ws + WS_WB) + (size_t)l * 3 * D * 512;
        const bf16* WoutT = (const bf16*)(ws + WS_WOUT) + (size_t)l * D * D;
        const bf16* WupT = (const bf16*)(ws + WS_WUP) + (size_t)l * FF * D;
        const bf16* WdnT = (const bf16*)(ws + WS_WDN) + (size_t)l * D * FF;

        if (PHON(1) && IN(pb + 0)) {
            pg8::Gemm g{XB, WinT, D, D, D}; pg8::StaticOrder S; S.init(M, ZW, F.G, (int)blockIdx.x);
            pg8::EpiZ E{Z, ZW, 2, 0.125f * 1.4426950408889634f};
            pg8::gemm_phase<pg8::EpiZ, pg8::StaticOrder, true>(F.lds, g, S, E);
            if (BOTH(pb + 0)) GRID_BAR();
        }
        if (PHON(2) && IN(pb + 1)) {
            const float lam_init = 0.8f - 0.6f * expf(-0.3f * (float)l);
            const float* lp = args.in[4] + l * 256;
            PHASE_IDS();
            const float lam = expf(wave_sum(lp[lane] * lp[64 + lane])) - expf(wave_sum(lp[128 + lane] * lp[192 + lane])) + lam_init;
            if (blockIdx.x < 128) {
                const int cu = blockIdx.x, bh = cu & 63;
                if (cu < 64) chain_naive_unit<0>(F, Z, bh >> 2, bh & 3, l, args);
                else chain_naive_unit<1>(F, Z, bh >> 2, bh & 3, l, args);
            }
            gu32* qhead = F.ctl + CW_QUEUE + 64 * l;
            for (;;) {
                __syncthreads();
                if (tid == 0) F.MISC[16] = __hip_atomic_fetch_add(qhead, 1u, RLX_AGENT);
                __syncthreads();
                const unsigned it = F.MISC[16];
                if (it >= 512u) break;
                const int qb = 7 - (int)(it >> 6), bh = (int)(it & 63u);
                att::attn_unit<8>(Z, bh >> 2, bh & 3, qb, lam, 1.0f - lam_init, args.in[5] + l * 128, F.lds);
            }
            if (BOTH(pb + 1)) GRID_BAR();
        }
        if (PHON(3) && IN(pb + 2)) {
            pg8::StaticOrder S; S.init(M, D, F.G, (int)blockIdx.x);
            for (int n = 0; n < 3; ++n) {
                { pg8::Gemm g{XB, WinT + (size_t)(ZW + n * D) * D, D, D, D};
                  pg8::EpiBf16<1> E{Z + ZC_GATE, ZW};
                  pg8::gemm_phase<pg8::EpiBf16<1>, pg8::StaticOrder, true>(F.lds, g, S, E); }
                VM_WAIT(); __syncthreads();
                { const int boff = (n == 0) ? ZC_QA : (n == 1) ? ZC_VG : ZC_IH;
                  pg8::Gemm g{Z + boff, WbT + (size_t)n * D * 512, 512, ZW, 512};
                  pg8::EpiMerge E{Z + ZC_MRG, Z + ZC_GATE, ZW, n == 0 ? 1 : 0};
                  pg8::gemm_phase<pg8::EpiMerge, pg8::StaticOrder, true>(F.lds, g, S, E); }
                VM_WAIT(); __syncthreads();
            }
            if (BOTH(pb + 2)) GRID_BAR();
        }
        if (PHON(4) && IN(pb + 3)) {
            pg8::Gemm g{Z + ZC_MRG, WoutT, D, ZW, D}; pg8::StaticOrder S; S.init(M, D, F.G, (int)blockIdx.x);
            pg8::EpiResF32 E{l == 0 ? args.in[0] : R, R, D, ALPHA};
            pg8::gemm_phase<pg8::EpiResF32, pg8::StaticOrder, true>(F.lds, g, S, E);
            if (BOTH(pb + 3)) GRID_BAR();
        }
        if (PHON(5) && IN(pb + 4)) { ln_phase(F, R, XB, args.in[11] + l * D, args.in[12] + l * D); if (BOTH(pb + 4)) GRID_BAR(); }
        if (PHON(6) && IN(pb + 5)) {
            pg8::Gemm g{XB, WupT, D, D, D}; pg8::StaticOrder S; S.init(M, FF, F.G, (int)blockIdx.x);
            pg8::EpiBf16<2> E{H, FF};
            pg8::gemm_phase<pg8::EpiBf16<2>, pg8::StaticOrder, true>(F.lds, g, S, E);
            if (BOTH(pb + 5)) GRID_BAR();
        }
        if (PHON(7) && IN(pb + 6)) {
            pg8::Gemm g{H, WdnT, FF, FF, FF}; pg8::StaticOrder S; S.init(M, D, F.G, (int)blockIdx.x);
            pg8::EpiResF32 E{R, R, D, ALPHA};
            pg8::gemm_phase<pg8::EpiResF32, pg8::StaticOrder, true>(F.lds, g, S, E);
            if (BOTH(pb + 6)) GRID_BAR();
        }
        if (PHON(8) && IN(pb + 7)) { ln_phase(F, R, XB, args.in[15] + l * D, args.in[16] + l * D); if (BOTH(pb + 7)) GRID_BAR(); }
    }
#undef IN
#undef BOTH
#undef GRID_BAR
}

extern "C" void kernel_launch(void* const* d_in, const int* in_sizes, int n_in, void* d_out, int out_size, void* d_ws, size_t ws_size, hipStream_t stream) {
    static int grid = 0;
    if (grid == 0) {
        if (n_in != 17 || in_sizes[0] != M * D || out_size != M * D || ws_size < WS_END) { fprintf(stderr, "kernel_launch: unexpected shapes / workspace (n_in %d, ws %zu); nothing launched\n", n_in, ws_size); grid = -1; return; }
        int dev = 0, cus = 0, per_cu = 0;
        if (hipGetDevice(&dev) != hipSuccess || hipDeviceGetAttribute(&cus, hipDeviceAttributeMultiprocessorCount, dev) != hipSuccess) { grid = -1; return; }
        if (hipFuncSetAttribute((const void*)skel_fwd, hipFuncAttributeMaxDynamicSharedMemorySize, LDS_BYTES) != hipSuccess) { fprintf(stderr, "kernel_launch: hipFuncSetAttribute failed\n"); grid = -1; return; }
        if (hipOccupancyMaxActiveBlocksPerMultiprocessor(&per_cu, (const void*)skel_fwd, NWAVES * 64, LDS_BYTES) != hipSuccess || per_cu < 1)
            fprintf(stderr, "kernel_launch: note: occupancy query reports %d workgroups per CU\n", per_cu);
        (void)hipGetLastError();
        grid = cus;
    }
    if (grid < 0) return;
    if (hipMemsetAsync((char*)d_ws + WS_CTL, 0, CTL_ZERO_BYTES, stream) != hipSuccess) return;
    Args a{};
    for (int i = 0; i < 17; ++i) a.in[i] = (const float*)d_in[i];
    a.out = (float*)d_out; a.ws = (unsigned char*)d_ws;
    if (MK_N_LAUNCHES == 1) {
        a.ph_lo = 0; a.ph_hi = NPHASE;
        hipLaunchKernelGGL(skel_fwd, dim3(grid), dim3(NWAVES * 64), LDS_BYTES, stream, a);
    } else {
        for (int p = 0; p < NPHASE; ++p) { a.ph_lo = p; a.ph_hi = p + 1; hipLaunchKernelGGL(skel_fwd, dim3(grid), dim3(NWAVES * 64), LDS_BYTES, stream, a); }
    }
}
```

```cpp
#include <hip/hip_runtime.h>
#include <cstdio>
#include <cstdint>

#ifndef MK_N_LAUNCHES
#define MK_N_LAUNCHES 1
#endif
#ifndef MK_PHASE_MASK
#define MK_PHASE_MASK 0x1ff
#endif

namespace pg8 {
#define PG8_LAS __attribute__((address_space(3)))
typedef unsigned short bf16_t;
typedef short bf16x8 __attribute__((ext_vector_type(8)));
typedef float f32x4 __attribute__((ext_vector_type(4)));
typedef unsigned u32x4 __attribute__((ext_vector_type(4)));
constexpr int BM = 256, BK = 64, HALF = 128, HTB = HALF * BK * 2, STAGE_BYTES = 8 * HTB, NXCD = 8, WGM = 8;

__host__ __device__ __forceinline__ int lds_byte(int r, int c) { const int st = (r >> 4) * 2 + (c >> 5), rr = r & 15, cc = c & 31, ob = rr * 64 + cc * 2; return st * 1024 + (ob ^ (((ob >> 9) & 1) << 5)); }
__host__ __device__ __forceinline__ void stage_rc(int b, int& R, int& C) { const int st = b / 1024, sb = b % 1024, swz = sb ^ (((sb >> 9) & 1) << 5); R = (st >> 1) * 16 + swz / 64; C = (st & 1) * 32 + (swz % 64) / 2; }
__host__ __device__ __forceinline__ int perm32(int rho) { const int n = rho >> 4, i = rho & 15; return 8 * (i >> 2) + 4 * n + (i & 3); }

struct Unit { int pm, pn; };
struct Gemm { const bf16_t* A; const bf16_t* Bt; int K, lda, ldb; };

struct StaticOrder {
    int nM, nN, nwg, G, c;
    __host__ __device__ void init(int M, int N, int G_, int c_) { nM = M / BM; nN = N / BM; nwg = nM * nN; G = G_; c = c_; }
    __host__ __device__ bool next(int i, Unit& u) const {
        const long L = (long)i * G + c; if (L >= nwg) return false;
        int wgid = (int)L; { const int q = nwg / NXCD, r = nwg % NXCD, xcd = wgid % NXCD, off = wgid / NXCD; wgid = (xcd < r ? xcd * (q + 1) : r * (q + 1) + (xcd - r) * q) + off; }
        const int nig = WGM * nN, gid = wgid / nig, fm = gid * WGM, gsz = (nM - fm) < WGM ? (nM - fm) : WGM;
        u.pm = fm + ((wgid % nig) % gsz); u.pn = (wgid % nig) / gsz; return true;
    }
    __device__ __forceinline__ void a_ready(const Unit&) const {}
    __device__ __forceinline__ void done(const Unit&) const {}
};

__device__ __forceinline__ unsigned cvt_pk_bf16(float lo, float hi) { unsigned r; asm volatile("v_cvt_pk_bf16_f32 %0, %1, %2" : "=v"(r) : "v"(lo), "v"(hi)); return r; }
__device__ __forceinline__ float bflo(unsigned w) { return __uint_as_float(w << 16); }
__device__ __forceinline__ float bfhi(unsigned w) { return __uint_as_float(w & 0xffff0000u); }

template <int ACT> struct EpiBf16 {
    static constexpr bool PERM = true;
    bf16_t* O; int ldc;
    __device__ __forceinline__ float act(float v) const {
        if (ACT == 1) return 1.0f / (1.0f + __expf(-v));
        if (ACT == 2) { const float r = fmaxf(v, 0.f); return r * r; }
        return v;
    }
    __device__ __forceinline__ void operator()(const f32x4 (&acc)[2][2][4][2], const Unit& u, int wr, int wc, int fr, int fq) const {
        const int row0 = u.pm * BM + wr * 64 + fr, col0 = u.pn * BM + wc * 32 + 8 * fq;
#pragma unroll
        for (int ai = 0; ai < 2; ++ai)
#pragma unroll
            for (int m = 0; m < 4; ++m) { bf16_t* rowp = O + (size_t)(row0 + ai * HALF + m * 16) * ldc + col0;
#pragma unroll
                for (int bj = 0; bj < 2; ++bj) { const f32x4 v0 = acc[ai][bj][m][0], v1 = acc[ai][bj][m][1];
                    u32x4 w; w.x = cvt_pk_bf16(act(v0[0]), act(v0[1])); w.y = cvt_pk_bf16(act(v0[2]), act(v0[3])); w.z = cvt_pk_bf16(act(v1[0]), act(v1[1])); w.w = cvt_pk_bf16(act(v1[2]), act(v1[3]));
                    *(u32x4*)(rowp + bj * HALF) = w; } }
    }
};
struct EpiZ {
    static constexpr bool PERM = true;
    bf16_t* O; int ldc; int nq; float qscale;
    __device__ __forceinline__ void operator()(const f32x4 (&acc)[2][2][4][2], const Unit& u, int wr, int wc, int fr, int fq) const {
        const int row0 = u.pm * BM + wr * 64 + fr, col0 = u.pn * BM + wc * 32 + 8 * fq;
        const float sc = (u.pn < nq) ? qscale : 1.0f;
#pragma unroll
        for (int ai = 0; ai < 2; ++ai)
#pragma unroll
            for (int m = 0; m < 4; ++m) { bf16_t* rowp = O + (size_t)(row0 + ai * HALF + m * 16) * ldc + col0;
#pragma unroll
                for (int bj = 0; bj < 2; ++bj) { const f32x4 v0 = acc[ai][bj][m][0] * sc, v1 = acc[ai][bj][m][1] * sc;
                    u32x4 w; w.x = cvt_pk_bf16(v0[0], v0[1]); w.y = cvt_pk_bf16(v0[2], v0[3]); w.z = cvt_pk_bf16(v1[0], v1[1]); w.w = cvt_pk_bf16(v1[2], v1[3]);
                    *(u32x4*)(rowp + bj * HALF) = w; } }
    }
};
struct EpiMerge {
    static constexpr bool PERM = true;
    bf16_t* Mg; const bf16_t* Gt; int ldc; int first;
    __device__ __forceinline__ void operator()(const f32x4 (&acc)[2][2][4][2], const Unit& u, int wr, int wc, int fr, int fq) const {
        const int row0 = u.pm * BM + wr * 64 + fr, col0 = u.pn * BM + wc * 32 + 8 * fq;
#pragma unroll
        for (int ai = 0; ai < 2; ++ai)
#pragma unroll
            for (int m = 0; m < 4; ++m) { const size_t ro = (size_t)(row0 + ai * HALF + m * 16) * ldc + col0;
#pragma unroll
                for (int bj = 0; bj < 2; ++bj) { const f32x4 v0 = acc[ai][bj][m][0], v1 = acc[ai][bj][m][1];
                    const u32x4 g = *(const u32x4*)(Gt + ro + bj * HALF);
                    u32x4 p = (u32x4){0u, 0u, 0u, 0u}; if (!first) p = *(const u32x4*)(Mg + ro + bj * HALF);
                    u32x4 w;
                    w.x = cvt_pk_bf16(bflo(p.x) + bflo(g.x) * v0[0], bfhi(p.x) + bfhi(g.x) * v0[1]);
                    w.y = cvt_pk_bf16(bflo(p.y) + bflo(g.y) * v0[2], bfhi(p.y) + bfhi(g.y) * v0[3]);
                    w.z = cvt_pk_bf16(bflo(p.z) + bflo(g.z) * v1[0], bfhi(p.z) + bfhi(g.z) * v1[1]);
                    w.w = cvt_pk_bf16(bflo(p.w) + bflo(g.w) * v1[2], bfhi(p.w) + bfhi(g.w) * v1[3]);
                    *(u32x4*)(Mg + ro + bj * HALF) = w; } }
    }
};
struct EpiResF32 {
    static constexpr bool PERM = false;
    const float* base; float* out; int ldc; float alpha;
    __device__ __forceinline__ void operator()(const f32x4 (&acc)[2][2][4][2], const Unit& u, int wr, int wc, int fr, int fq) const {
        const int row0 = u.pm * BM + wr * 64 + fr, col0 = u.pn * BM + wc * 32 + 4 * fq;
#pragma unroll
        for (int ai = 0; ai < 2; ++ai)
#pragma unroll
            for (int m = 0; m < 4; ++m) { const size_t ro = (size_t)(row0 + ai * HALF + m * 16) * ldc + col0;
#pragma unroll
                for (int bj = 0; bj < 2; ++bj)
#pragma unroll
                    for (int n = 0; n < 2; ++n) { const f32x4 bs = *(const f32x4*)(base + ro + bj * HALF + n * 16);
                        *(f32x4*)(out + ro + bj * HALF + n * 16) = bs * alpha + acc[ai][bj][m][n]; } }
    }
};

template <class Epi, class Sched, bool ALIGN_EPI = false>
__device__ __forceinline__ void gemm_phase(PG8_LAS unsigned char* lds, const Gemm g, const Sched& S, const Epi& E) {
    int tid_ = threadIdx.x; asm volatile("" : "+v"(tid_));
    const int tid = tid_, wid = __builtin_amdgcn_readfirstlane(tid >> 6), lane = tid & 63, wr = wid >> 2, wc = wid & 3, fr = lane & 15, fq = lane >> 4;
    const int K = g.K, nt = K / BK;
    unsigned voffA[2], voffB[2];
#pragma unroll
    for (int i = 0; i < 2; ++i) { int R, C; stage_rc(tid * 16 + i * 8192, R, C); const int Rb = Epi::PERM ? ((R & ~31) + perm32(R & 31)) : R;
        voffA[i] = (unsigned)(R * g.lda + C) * 2u; voffB[i] = (unsigned)(Rb * g.ldb + C) * 2u; }
    const size_t kstep = (size_t)(BK * 2);
    const size_t hstepA = (size_t)HALF * g.lda * 2, hstepB = (size_t)HALF * g.ldb * 2;
    const size_t tstepA = 2 * hstepA, tstepB = 2 * hstepB;
    const unsigned ldsw = (unsigned)wid * 1024u;
    const int aoff = lds_byte(wr * 64 + fr, fq * 8), boff = lds_byte(wc * 32 + fr, fq * 8);
#define PG8_SA(b, h) (((b) * 2 + (h)) * HTB)
#define PG8_SB(b, h) ((4 + (b) * 2 + (h)) * HTB)
#define PG8_STAGE(bufoff, gbase, voff) do { _Pragma("unroll") for (int _i = 0; _i < 2; ++_i) \
        __builtin_amdgcn_global_load_lds((const unsigned*)((const char*)(gbase) + (voff)[_i]), (PG8_LAS unsigned*)(lds + (bufoff) + ldsw + _i * 8192), 16, 0, 0); } while (0)
#define PG8_LDA(dst, b, h) do { _Pragma("unroll") for (int m = 0; m < 4; ++m) _Pragma("unroll") for (int k = 0; k < 2; ++k) dst[m][k] = *(const PG8_LAS bf16x8*)(lds + PG8_SA(b, h) + aoff + m * 2048 + k * 1024); } while (0)
#define PG8_LDB(dst, b, h) do { _Pragma("unroll") for (int n = 0; n < 2; ++n) _Pragma("unroll") for (int k = 0; k < 2; ++k) dst[n][k] = *(const PG8_LAS bf16x8*)(lds + PG8_SB(b, h) + boff + n * 2048 + k * 1024); } while (0)
#define PG8_MMA(ai, bj, At, Bt) do { __builtin_amdgcn_s_setprio(1); _Pragma("unroll") for (int m = 0; m < 4; ++m) _Pragma("unroll") for (int n = 0; n < 2; ++n) _Pragma("unroll") for (int k = 0; k < 2; ++k) \
        acc[ai][bj][m][n] = __builtin_amdgcn_mfma_f32_16x16x32_bf16(Bt[n][k], At[m][k], acc[ai][bj][m][n], 0, 0, 0); __builtin_amdgcn_s_setprio(0); } while (0)
#define PG8_WAIT_V(n) asm volatile("s_waitcnt vmcnt(" #n ")" ::: "memory")
#define PG8_WAIT_L(n) asm volatile("s_waitcnt lgkmcnt(" #n ")" ::: "memory")
#define PG8_BAR __builtin_amdgcn_s_barrier()
#define PG8_SCHED __builtin_amdgcn_sched_barrier(0)
    Unit cur, nxt; int ui = 0;
    if (!S.next(0, cur)) return;
    f32x4 acc[2][2][4][2];
#pragma unroll
    for (int a = 0; a < 2; ++a)
#pragma unroll
        for (int b = 0; b < 2; ++b)
#pragma unroll
            for (int m = 0; m < 4; ++m)
#pragma unroll
                for (int n = 0; n < 2; ++n) acc[a][b][m][n] = (f32x4){0.f, 0.f, 0.f, 0.f};
    bf16x8 At[4][2], B0[2][2], B1[2][2];
    const char* cA = (const char*)g.A + (size_t)cur.pm * tstepA; const char* cB = (const char*)g.Bt + (size_t)cur.pn * tstepB;
    S.a_ready(cur);
    PG8_STAGE(PG8_SB(0, 0), cB, voffB); PG8_STAGE(PG8_SB(0, 1), cB + hstepB, voffB); PG8_STAGE(PG8_SA(0, 0), cA, voffA); PG8_STAGE(PG8_SA(0, 1), cA + hstepA, voffA);
    if (wr == 1) PG8_BAR;
    PG8_WAIT_V(2); PG8_BAR;
    PG8_STAGE(PG8_SB(1, 0), cB + kstep, voffB); PG8_STAGE(PG8_SA(1, 0), cA + kstep, voffA); PG8_STAGE(PG8_SB(1, 1), cB + hstepB + kstep, voffB);
    PG8_WAIT_V(6); PG8_BAR;
    for (;;) {
        const bool has_next = S.next(ui + 1, nxt);
        const char* nA = has_next ? (const char*)g.A + (size_t)nxt.pm * tstepA : cA; const char* nB = has_next ? (const char*)g.Bt + (size_t)nxt.pn * tstepB : cB;
        for (int t = 0; t < nt; t += 2) {
            const bool last = (t == nt - 2);
            const char* a1 = cA + (size_t)(t + 1) * kstep;
            const char* a2 = last ? nA : cA + (size_t)(t + 2) * kstep; const char* b2 = last ? nB : cB + (size_t)(t + 2) * kstep;
            const char* a3 = a2 + kstep; const char* b3 = b2 + kstep;
            if (last && has_next) S.a_ready(nxt);
            PG8_LDB(B0, 0, 0); PG8_LDB(B1, 0, 1); PG8_SCHED; PG8_LDA(At, 0, 0); PG8_STAGE(PG8_SA(1, 1), a1 + hstepA, voffA);
            PG8_WAIT_V(8); PG8_WAIT_L(0); PG8_BAR; PG8_MMA(0, 0, At, B0); PG8_MMA(0, 1, At, B1); PG8_BAR; PG8_SCHED;
            PG8_LDA(At, 0, 1); PG8_STAGE(PG8_SB(0, 0), b2, voffB); PG8_STAGE(PG8_SB(0, 1), b2 + hstepB, voffB); PG8_STAGE(PG8_SA(0, 0), a2, voffA);
            PG8_WAIT_V(8); PG8_WAIT_L(0); PG8_BAR; PG8_MMA(1, 0, At, B0); PG8_MMA(1, 1, At, B1); PG8_BAR; PG8_SCHED;
            PG8_LDB(B0, 1, 0); PG8_LDB(B1, 1, 1); PG8_SCHED; PG8_LDA(At, 1, 0); PG8_STAGE(PG8_SA(0, 1), a2 + hstepA, voffA);
            PG8_WAIT_V(8); PG8_WAIT_L(0); PG8_BAR; PG8_MMA(0, 0, At, B0); PG8_MMA(0, 1, At, B1); PG8_BAR; PG8_SCHED;
            PG8_LDA(At, 1, 1); PG8_STAGE(PG8_SB(1, 0), b3, voffB); PG8_STAGE(PG8_SB(1, 1), b3 + hstepB, voffB); PG8_STAGE(PG8_SA(1, 0), a3, voffA);
            PG8_WAIT_V(8); PG8_WAIT_L(0); PG8_BAR; PG8_MMA(1, 0, At, B0); PG8_MMA(1, 1, At, B1); PG8_BAR; PG8_SCHED;
        }
        if constexpr (ALIGN_EPI) { if (wr == 0) PG8_BAR; }
        E(acc, cur, wr, wc, fr, fq); S.done(cur);
        if (!has_next) break;
#pragma unroll
        for (int a = 0; a < 2; ++a)
#pragma unroll
            for (int b = 0; b < 2; ++b)
#pragma unroll
                for (int m = 0; m < 4; ++m)
#pragma unroll
                    for (int n = 0; n < 2; ++n) acc[a][b][m][n] = (f32x4){0.f, 0.f, 0.f, 0.f};
        cur = nxt; cA = nA; cB = nB; ++ui;
        if constexpr (ALIGN_EPI) { if (wr == 1) PG8_BAR; }
    }
    PG8_WAIT_V(0);
    if constexpr (!ALIGN_EPI) { if (wr == 0) PG8_BAR; }
    PG8_BAR;
#undef PG8_SA
#undef PG8_SB
#undef PG8_STAGE
#undef PG8_LDA
#undef PG8_LDB
#undef PG8_MMA
#undef PG8_WAIT_V
#undef PG8_WAIT_L
#undef PG8_BAR
#undef PG8_SCHED
}
}

constexpr int NWAVES = 8;
constexpr int BATCH = 16, T = 2048, D = 1024, M = BATCH * T, FF = 4096, DEPTH = 2;
constexpr int IN_WIDTH = 8208;
constexpr int ZW = 5376;
constexpr int ZC_QA = 0, ZC_KA = 512, ZC_VA = 1024, ZC_QG = 1536, ZC_KG = 1792, ZC_VG = 2048, ZC_GO = 2560, ZC_QH = 3072, ZC_FH = 3584, ZC_IH = 4096, ZC_HO = 4608, ZC_GLR = 5120;
constexpr int ZC_MRG = 512;
constexpr int ZC_GATE = 3072;
constexpr int NWIN = ZW + 3 * D;
constexpr float LN_EPS = 1e-5f;
constexpr float ALPHA = 1.41421356237309515f;
constexpr int NPHASE = 1 + 8 * DEPTH;

constexpr size_t MiB = 1u << 20;
constexpr size_t WS_CTL = 0, CTL_ZERO_BYTES = 1 * MiB;
constexpr size_t WS_WIN = 1 * MiB;
constexpr size_t WS_WB = 34 * MiB;
constexpr size_t WS_WOUT = 40 * MiB;
constexpr size_t WS_WUP = 44 * MiB;
constexpr size_t WS_WDN = 60 * MiB;
constexpr size_t WS_XB = 76 * MiB;
constexpr size_t WS_Z = 140 * MiB;
constexpr size_t WS_END = 476 * MiB;
static_assert(WS_WIN + (size_t)DEPTH * NWIN * D * 2 <= WS_WB && WS_Z + (size_t)M * ZW * 2 <= WS_END, "d_ws map");
constexpr int CW_BAR = 4096;
constexpr int CW_QUEUE = 16384;

constexpr int RING_BYTES = 147456;
constexpr int LDSCTL_OFF = RING_BYTES, MISC_OFF = LDSCTL_OFF + 320;
constexpr int LDS_BYTES = RING_BYTES + 1024;

#define GAS __attribute__((address_space(1)))
#define LAS __attribute__((address_space(3)))
typedef unsigned short bf16;
typedef unsigned v4u __attribute__((ext_vector_type(4)));
typedef unsigned v2u __attribute__((ext_vector_type(2)));
typedef float f32x4 __attribute__((ext_vector_type(4)));
typedef GAS unsigned gu32;
#define RLX_AGENT __ATOMIC_RELAXED, __HIP_MEMORY_SCOPE_AGENT
#define LDS_WAIT() asm volatile("s_waitcnt lgkmcnt(0)" ::: "memory")
#define VM_WAIT() asm volatile("s_waitcnt vmcnt(0)" ::: "memory")
__device__ __forceinline__ unsigned f2bf(float f) { unsigned u = __builtin_bit_cast(unsigned, f); return (u + 0x7fffu + ((u >> 16) & 1u)) >> 16; }
__device__ __forceinline__ unsigned pk2(float lo, float hi) { return f2bf(lo) | (f2bf(hi) << 16); }
__device__ __forceinline__ float bf2f(unsigned short b) { return __uint_as_float((unsigned)b << 16); }
__device__ __forceinline__ float wave_sum(float v) {
#pragma unroll
    for (int o = 1; o < 64; o <<= 1) v += __shfl_xor(v, o);
    return v;
}
__device__ __forceinline__ float wave_max(float v) {
#pragma unroll
    for (int o = 1; o < 64; o <<= 1) v = fmaxf(v, __shfl_xor(v, o));
    return v;
}
__device__ __forceinline__ float logsigmoidf(float x) { return fminf(x, 0.f) - log1pf(expf(-fabsf(x))); }

#define XB_TMO      128
#define XB_XCNT(j)  (256  + 64 * (j))
#define XB_XSUB(j)  (1280 + 64 * (j))
#define XB_XGEN(j)  (2304 + 64 * (j))
#define XB_TOP      3328
#define XB_TOPGEN   3392
#define XCD_BAR_WORDS 3456
#define XB_SPIN_CAP (1u << 18)

__device__ __forceinline__ unsigned xb_ld(unsigned* p)              { return __hip_atomic_load(p, __ATOMIC_RELAXED, __HIP_MEMORY_SCOPE_AGENT); }
__device__ __forceinline__ unsigned xb_add(unsigned* p, unsigned v) { return __hip_atomic_fetch_add(p, v, __ATOMIC_RELAXED, __HIP_MEMORY_SCOPE_AGENT); }
__device__ __forceinline__ unsigned xb_xcc_id() { return (unsigned)__builtin_amdgcn_s_getreg((3 << 11) | 20) & 0xFu; }
#define XB_SPIN(cond, bar) do { unsigned _sp = 0; while (cond) { __builtin_amdgcn_s_sleep(1); \
    if ((++_sp & 255u) == 0u) { if (xb_ld(&(bar)[XB_TMO])) break; if (_sp > XB_SPIN_CAP) { atomicAdd(&(bar)[XB_TMO], 1u); break; } } } } while (0)

struct XcdBarrier {
    unsigned* bar; unsigned x;
    volatile LAS unsigned* st;
};
__device__ __forceinline__ XcdBarrier xcd_barrier_post(unsigned* bar, volatile LAS unsigned* st) {
    XcdBarrier b; b.bar = bar; b.x = xb_xcc_id(); b.st = st;
    if (threadIdx.x == 0) (void)xb_add(&bar[XB_XCNT(b.x)], 1u);
    return b;
}
__device__ __forceinline__ void xcd_barrier_complete(unsigned* bar, unsigned x, unsigned& nloc, unsigned& nx) {
    const unsigned G = gridDim.x * gridDim.y * gridDim.z;
    unsigned sum, cnt, mine, sp = 0u;
    for (;;) {
        sum = 0u; cnt = 0u; mine = 0u;
#pragma unroll
        for (unsigned j = 0; j < 16; ++j) { const unsigned c = xb_ld(&bar[XB_XCNT(j)]); sum += c; cnt += (c > 0u) ? 1u : 0u; mine = (j == x) ? c : mine; }
        if (sum == G) break;
        __builtin_amdgcn_s_sleep(1);
        if ((++sp & 255u) == 0u) { if (xb_ld(&bar[XB_TMO])) break; if (sp > XB_SPIN_CAP) { atomicAdd(&bar[XB_TMO], 1u); break; } }
    }
    nloc = mine > 0u ? mine : 1u; nx = cnt > 0u ? cnt : 1u;
}
__device__ __forceinline__ void xcd_barrier(const XcdBarrier& b) {
    asm volatile("s_waitcnt vmcnt(0)" ::: "memory");
    __syncthreads();
    if (threadIdx.x == 0) {
        unsigned* bar = b.bar;
        __builtin_amdgcn_s_waitcnt(0);
        unsigned nloc = b.st[0], nx = b.st[1];
        if (nloc == 0u) { xcd_barrier_complete(bar, b.x, nloc, nx); b.st[0] = nloc; b.st[1] = nx; }
        const unsigned old = xb_add(&bar[XB_XSUB(b.x)], 1u);
        const unsigned gen = old / nloc;
        if (old + 1u == (gen + 1u) * nloc) {
            __builtin_amdgcn_fence(__ATOMIC_RELEASE, "agent");
            asm volatile("s_waitcnt vmcnt(0)" ::: "memory");
            const unsigned og = xb_add(&bar[XB_TOP], 1u);
            const unsigned tg = og / nx;
            if (og + 1u == (tg + 1u) * nx) xb_add(&bar[XB_TOPGEN], 1u);
            else XB_SPIN(xb_ld(&bar[XB_TOPGEN]) == tg, bar);
            __builtin_amdgcn_fence(__ATOMIC_ACQUIRE, "agent");
            xb_add(&bar[XB_XGEN(b.x)], 1u);
            asm volatile("s_waitcnt vmcnt(0)" ::: "memory");
        } else {
            XB_SPIN(xb_ld(&bar[XB_XGEN(b.x)]) == gen, bar);
            __builtin_amdgcn_fence(__ATOMIC_ACQUIRE, "agent");
            asm volatile("s_waitcnt vmcnt(0)" ::: "memory");
        }
    }
    __syncthreads();
}

struct Frame {
    LAS unsigned char* lds;
    volatile LAS unsigned* MISC;
    gu32* ctl;
    int vcu, G;
};
#define PHASE_IDS() int tid_o_ = threadIdx.x; asm volatile("" : "+v"(tid_o_)); const int tid = tid_o_, lane = tid & 63, wave = __builtin_amdgcn_readfirstlane(tid >> 6); (void)tid; (void)lane; (void)wave

__device__ __forceinline__ int win_src_col(int j) {
    if (j < 2560) return j;
    if (j < 5120) return j + 16;
    if (j < 5136) return j - 5120 + 2560;
    if (j < ZW) return -1;
    return j - ZW + 5136;
}
template <bool MAPWIN>
__device__ __forceinline__ void p0_transpose_item(const float* W, int K, int Nsrc, int Ndst, bf16* WT, LAS float* scr, int item, int lane) {
    const int nblk = Ndst / 32, kb = item / nblk, nb = item % nblk, k0 = 64 * kb, n0 = 32 * nb;
    const int nd = n0 + (lane & 31); const int sc = MAPWIN ? win_src_col(nd) : nd;
#pragma unroll 8
    for (int i = 0; i < 32; ++i) { const int kk = 2 * i + (lane >> 5); scr[kk * 33 + (lane & 31)] = (sc >= 0) ? W[(size_t)(k0 + kk) * Nsrc + sc] : 0.f; }
    LDS_WAIT(); asm volatile("" ::: "memory");
    const int c = lane & 7;
#pragma unroll
    for (int j = 0; j < 4; ++j) { const int n = (lane >> 3) + 8 * j; const LAS float* s = scr + (8 * c) * 33 + n;
        v4u o; o.x = pk2(s[0 * 33], s[1 * 33]); o.y = pk2(s[2 * 33], s[3 * 33]); o.z = pk2(s[4 * 33], s[5 * 33]); o.w = pk2(s[6 * 33], s[7 * 33]);
        *(GAS v4u*)(WT + (size_t)(n0 + n) * K + k0 + 8 * c) = o; }
    LDS_WAIT(); asm volatile("" ::: "memory");
}

struct Args { const float* in[17]; float* out; unsigned char* ws; int ph_lo, ph_hi; };

__device__ __forceinline__ void p0_prologue(Frame& F, const Args& a) {
    PHASE_IDS();
    LAS float* scr = (LAS float*)(F.lds + wave * 16384);
    const int gw = F.vcu * NWAVES + wave, NGW = F.G * NWAVES;
    constexpr int I_IN = (D / 64) * (NWIN / 32), I_BR = (512 / 64) * (D / 32), I_OUT = (D / 64) * (D / 32), I_UP = (D / 64) * (FF / 32), I_DN = (FF / 64) * (D / 32);
    constexpr int PER_LAYER = I_IN + 3 * I_BR + I_OUT + I_UP + I_DN;
    for (int it = gw; it < DEPTH * PER_LAYER; it += NGW) {
        const int l = it / PER_LAYER; int r = it % PER_LAYER;
        if (r < I_IN) { p0_transpose_item<true>(a.in[1] + (size_t)l * D * IN_WIDTH, D, IN_WIDTH, NWIN, (bf16*)(a.ws + WS_WIN) + (size_t)l * NWIN * D, scr, r, lane); continue; } r -= I_IN;
        if (r < 3 * I_BR) { const int n = r / I_BR; p0_transpose_item<false>(a.in[9] + (size_t)(l * 3 + n) * 512 * D, 512, D, D, (bf16*)(a.ws + WS_WB) + (size_t)(l * 3 + n) * D * 512, scr, r % I_BR, lane); continue; } r -= 3 * I_BR;
        if (r < I_OUT) { p0_transpose_item<false>(a.in[10] + (size_t)l * D * D, D, D, D, (bf16*)(a.ws + WS_WOUT) + (size_t)l * D * D, scr, r, lane); continue; } r -= I_OUT;
        if (r < I_UP) { p0_transpose_item<false>(a.in[13] + (size_t)l * D * FF, D, FF, FF, (bf16*)(a.ws + WS_WUP) + (size_t)l * FF * D, scr, r, lane); continue; } r -= I_UP;
        p0_transpose_item<false>(a.in[14] + (size_t)l * FF * D, FF, D, D, (bf16*)(a.ws + WS_WDN) + (size_t)l * D * FF, scr, r, lane);
    }
    const float* x = a.in[0]; bf16* XB = (bf16*)(a.ws + WS_XB);
    for (int m = gw; m < M; m += NGW) {
        const GAS f32x4* xr = (const GAS f32x4*)(x + (size_t)m * D) + lane;
        GAS unsigned long long* o8 = (GAS unsigned long long*)(XB + (size_t)m * D) + lane;
#pragma unroll
        for (int j = 0; j < 4; ++j) { const f32x4 v = xr[64 * j]; o8[64 * j] = (unsigned long long)pk2(v.x, v.y) | ((unsigned long long)pk2(v.z, v.w) << 32); }
    }
}

__device__ __forceinline__ void ln_phase(Frame& F, float* R, bf16* XB, const float* w, const float* b) {
    PHASE_IDS();
    const int gw = F.vcu * NWAVES + wave, NGW = F.G * NWAVES;
    f32x4 wv[4], bv[4];
#pragma unroll
    for (int j = 0; j < 4; ++j) { wv[j] = ((const f32x4*)w)[lane + 64 * j]; bv[j] = ((const f32x4*)b)[lane + 64 * j]; }
    for (int m = gw; m < M; m += NGW) {
        GAS f32x4* xr = (GAS f32x4*)(R + (size_t)m * D) + lane;
        f32x4 v[4]; float s = 0.f;
#pragma unroll
        for (int j = 0; j < 4; ++j) { v[j] = xr[64 * j]; s += (v[j].x + v[j].y) + (v[j].z + v[j].w); }
        const float mean = wave_sum(s) * (1.f / D); float s2 = 0.f;
#pragma unroll
        for (int j = 0; j < 4; ++j) { v[j] = v[j] - mean; s2 += (v[j].x * v[j].x + v[j].y * v[j].y) + (v[j].z * v[j].z + v[j].w * v[j].w); }
        const float rstd = 1.f / sqrtf(wave_sum(s2) * (1.f / D) + LN_EPS);
        GAS unsigned long long* o8 = (GAS unsigned long long*)(XB + (size_t)m * D) + lane;
#pragma unroll
        for (int j = 0; j < 4; ++j) { const f32x4 y = v[j] * rstd * wv[j] + bv[j]; xr[64 * j] = y;
            o8[64 * j] = (unsigned long long)pk2(y.x, y.y) | ((unsigned long long)pk2(y.z, y.w) << 32); }
    }
}

__device__ __forceinline__ void attn_naive_item(Frame& F, bf16* Z, int b, int h, int rb, float lam, float post, const float* normw) {
    PHASE_IDS();
    LAS float* sb1 = (LAS float*)(F.lds + wave * 16384);
    LAS float* sb2 = sb1 + 2048;
    LAS float* qb = (LAS float*)(F.lds + 131072 + wave * 512);
    const float slope = exp2f(-2.0f * (float)(h + 1));
    const bf16* zb = Z + (size_t)b * T * ZW;
    for (int rr = 0; rr < 8; ++rr) {
        const int i = rb * 64 + wave * 8 + rr;
        const bf16* qrow = zb + (size_t)i * ZW + ZC_QA + h * 128;
        qb[lane] = bf2f(qrow[lane]) * 0.125f; qb[64 + lane] = bf2f(qrow[64 + lane]) * 0.125f;
        LDS_WAIT();
        float m1 = -1e30f, m2 = -1e30f;
        for (int j0 = 0; j0 <= i; j0 += 64) {
            const int j = j0 + lane;
            if (j <= i) {
                const bf16* krow = zb + (size_t)j * ZW + ZC_KA + h * 128;
                float d1 = 0.f, d2 = 0.f;
#pragma unroll
                for (int c = 0; c < 8; ++c) {
                    const v4u k1 = *(const v4u*)(krow + c * 8), k2 = *(const v4u*)(krow + 64 + c * 8);
                    const f32x4 qa = *(const LAS f32x4*)(qb + c * 8), qc = *(const LAS f32x4*)(qb + c * 8 + 4);
                    const f32x4 qd = *(const LAS f32x4*)(qb + 64 + c * 8), qe = *(const LAS f32x4*)(qb + 64 + c * 8 + 4);
                    d1 += qa.x * pg8::bflo(k1.x) + qa.y * pg8::bfhi(k1.x) + qa.z * pg8::bflo(k1.y) + qa.w * pg8::bfhi(k1.y)
                        + qc.x * pg8::bflo(k1.z) + qc.y * pg8::bfhi(k1.z) + qc.z * pg8::bflo(k1.w) + qc.w * pg8::bfhi(k1.w);
                    d2 += qd.x * pg8::bflo(k2.x) + qd.y * pg8::bfhi(k2.x) + qd.z * pg8::bflo(k2.y) + qd.w * pg8::bfhi(k2.y)
                        + qe.x * pg8::bflo(k2.z) + qe.y * pg8::bfhi(k2.z) + qe.z * pg8::bflo(k2.w) + qe.w * pg8::bfhi(k2.w);
                }
                const float bias = slope * (float)(i - j);
                const float s1 = d1 - bias, s2 = d2 - bias;
                sb1[j] = s1; sb2[j] = s2; m1 = fmaxf(m1, s1); m2 = fmaxf(m2, s2);
            }
        }
        m1 = wave_max(m1); m2 = wave_max(m2);
        float l1 = 0.f, l2 = 0.f;
        for (int j0 = 0; j0 <= i; j0 += 64) { const int j = j0 + lane;
            if (j <= i) { const float e1 = expf(sb1[j] - m1), e2 = expf(sb2[j] - m2); sb1[j] = e1; sb2[j] = e2; l1 += e1; l2 += e2; } }
        l1 = wave_sum(l1); l2 = wave_sum(l2);
        const float r1 = 1.0f / l1, r2 = lam / l2;
        for (int j0 = 0; j0 <= i; j0 += 64) { const int j = j0 + lane; if (j <= i) sb1[j] = sb1[j] * r1 - sb2[j] * r2; }
        LDS_WAIT();
        float a0 = 0.f, a1 = 0.f;
        const bf16* vcol = zb + ZC_VA + h * 128 + 2 * lane;
#pragma unroll 4
        for (int j = 0; j <= i; ++j) { const float a = sb1[j]; const unsigned vv = *(const unsigned*)(vcol + (size_t)j * ZW); a0 += a * pg8::bflo(vv); a1 += a * pg8::bfhi(vv); }
        const float ss = wave_sum(a0 * a0 + a1 * a1) * (1.0f / 128.0f);
        const float r = post / sqrtf(ss + LN_EPS);
        const float o0 = a0 * r * normw[2 * lane], o1 = a1 * r * normw[2 * lane + 1];
        *(GAS unsigned*)((bf16*)zb + (size_t)i * ZW + ZC_QA + h * 128 + 2 * lane) = pk2(o0, o1);
        LDS_WAIT();
    }
}

template <int MIXER>
__device__ __forceinline__ void chain_naive_unit(Frame& F, bf16* Z, int b, int h, int l, const Args& a) {
    constexpr int DK = MIXER == 0 ? 64 : 128, DKS = DK / 4, CH = 32;
    constexpr int ZQ = MIXER == 0 ? ZC_QG : ZC_QH, ZK = MIXER == 0 ? ZC_KG : ZC_FH, ZV = MIXER == 0 ? ZC_VG : ZC_IH, ZG = MIXER == 0 ? ZC_GO : ZC_HO;
    LAS float* ge = (LAS float*)F.lds;
    LAS float* qs = ge + CH * DK;
    LAS float* ks = qs + CH * DK;
    LAS float* vs = (LAS float*)(F.lds + 49152);
    LAS float* op = (LAS float*)(F.lds + 65536);
    PHASE_IDS();
    const int col = tid & 127, sl = tid >> 7;
    bf16* zb = Z + (size_t)b * T * ZW;
    const float* normw = (MIXER == 0 ? a.in[6] : a.in[7]) + l * 128;
    const float* Wg = a.in[2] + (size_t)l * 16 * 256; const float* bg = a.in[3] + l * 256;
    const float* lbp = a.in[8];
    float S[DKS];
#pragma unroll
    for (int d = 0; d < DKS; ++d) S[d] = 0.f;
    for (int c0 = 0; c0 < T; c0 += CH) {
        for (int idx = tid; idx < CH * DK; idx += 512) {
            const int t = idx / DK, d = idx % DK; const bf16* zr = zb + (size_t)(c0 + t) * ZW;
            float lg, kv, qv;
            if (MIXER == 0) {
                float pre = bg[h * 64 + d];
#pragma unroll
                for (int r = 0; r < 16; ++r) pre += bf2f(zr[ZC_GLR + r]) * Wg[r * 256 + h * 64 + d];
                lg = logsigmoidf(pre) * (1.0f / 16.0f); kv = bf2f(zr[ZK + h * DK + d]); qv = bf2f(zr[ZQ + h * DK + d]) * 0.125f;
            } else {
                const int c = h * 128 + d; const float x0 = lbp[c], x1 = lbp[512 + c], mx = fmaxf(x0, x1), e0 = expf(x0 - mx), e1 = expf(x1 - mx);
                const float lb = (l == 0) ? 0.f : e1 / (e0 + e1);
                const float aa = logf(fmaxf(lb, 1e-30f)), bb = log1pf(-lb) + logsigmoidf(bf2f(zr[ZK + c]));
                lg = fmaxf(aa, bb) + log1pf(expf(-fabsf(aa - bb))); kv = -expm1f(lg); qv = bf2f(zr[ZQ + c]);
            }
            ge[idx] = expf(lg); ks[idx] = kv; qs[idx] = qv;
        }
        for (int idx = tid; idx < CH * 128; idx += 512) { const int t = idx >> 7, c = idx & 127; vs[idx] = bf2f(zb[(size_t)(c0 + t) * ZW + ZV + h * 128 + c]); }
        __syncthreads();
        for (int t = 0; t < CH; ++t) {
            const float v = vs[t * 128 + col]; float o = 0.f;
#pragma unroll
            for (int d4 = 0; d4 < DKS; d4 += 4) {
                const f32x4 g4 = *(const LAS f32x4*)(ge + t * DK + sl * DKS + d4), k4 = *(const LAS f32x4*)(ks + t * DK + sl * DKS + d4), q4 = *(const LAS f32x4*)(qs + t * DK + sl * DKS + d4);
                S[d4 + 0] = g4.x * S[d4 + 0] + k4.x * v; o += q4.x * S[d4 + 0];
                S[d4 + 1] = g4.y * S[d4 + 1] + k4.y * v; o += q4.y * S[d4 + 1];
                S[d4 + 2] = g4.z * S[d4 + 2] + k4.z * v; o += q4.z * S[d4 + 2];
                S[d4 + 3] = g4.w * S[d4 + 3] + k4.w * v; o += q4.w * S[d4 + 3];
            }
            op[(sl * CH + t) * 128 + col] = o;
        }
        __syncthreads();
#pragma unroll
        for (int tt = 0; tt < 4; ++tt) {
            const int t = wave * 4 + tt, c = 2 * lane;
            float o0 = 0.f, o1 = 0.f;
#pragma unroll
            for (int s = 0; s < 4; ++s) { o0 += op[(s * CH + t) * 128 + c]; o1 += op[(s * CH + t) * 128 + c + 1]; }
            const float ss = wave_sum(o0 * o0 + o1 * o1) * (1.0f / 128.0f), r = 1.0f / sqrtf(ss + LN_EPS);
            bf16* zr = zb + (size_t)(c0 + t) * ZW;
            const unsigned gw2 = *(const unsigned*)(zr + ZG + h * 128 + c);
            const float g0 = pg8::bflo(gw2), g1 = pg8::bfhi(gw2);
            const float y0 = o0 * r * normw[c] * (g0 / (1.0f + expf(-g0))), y1 = o1 * r * normw[c + 1] * (g1 / (1.0f + expf(-g1)));
            *(GAS unsigned*)(zr + ZV + h * 128 + c) = pk2(y0, y1);
        }
        __syncthreads();
    }
}

namespace att {
typedef short bf16x8 __attribute__((ext_vector_type(8)));
typedef short s16x4 __attribute__((ext_vector_type(4)));
typedef short v4i16_t __attribute__((ext_vector_type(4)));
typedef float f32x16 __attribute__((ext_vector_type(16)));
typedef unsigned u32x4 __attribute__((ext_vector_type(4)));
typedef float f32x4_t __attribute__((ext_vector_type(4)));
constexpr float QSCALE = 0.125f * 1.4426950408889634f;
constexpr int SLOT = 32768, OFF_V = 16384, OFF_Q = 65536, OFF_WS = 131072;
__device__ __forceinline__ int crow(int r, int hi) { return (r & 3) + 8 * (r >> 2) + 4 * hi; }
__device__ __forceinline__ void glds16(const void* gsrc, unsigned lds_dst) { unsigned keep;
    asm volatile("s_mov_b32 %0, m0\n\ts_mov_b32 m0, %2\n\ts_nop 0\n\tglobal_load_lds_dwordx4 %1, off\n\ts_mov_b32 m0, %0" : "=&s"(keep) : "v"(gsrc), "s"(lds_dst) : "memory"); }
typedef float f32x2_t __attribute__((ext_vector_type(2))); typedef __bf16 bf16x2_t __attribute__((ext_vector_type(2)));
__device__ __forceinline__ unsigned cvtpk(float lo, float hi) { f32x2_t v = {lo, hi}; bf16x2_t b = __builtin_convertvector(v, bf16x2_t); return __builtin_bit_cast(unsigned, b); }
__device__ __forceinline__ s16x4 vtr(const LAS unsigned char* p) { return __builtin_bit_cast(s16x4, __builtin_amdgcn_ds_read_tr16_b64_v4i16((LAS v4i16_t*)p)); }
#define ATT_WAIT_BAR() asm volatile("s_waitcnt vmcnt(0) lgkmcnt(0)\n\ts_barrier" ::: "memory")

template <int THRL>
__device__ __forceinline__ void attn_unit(bf16* Z, int b, int h, int qb, float lam, float post, const float* normw, LAS unsigned char* lds) {
    PHASE_IDS();
    const int r32 = lane & 31, hi = lane >> 5;
    bf16* zb = Z + (size_t)b * T * ZW;
    const int q0 = qb * 256;
    const unsigned lds0 = (unsigned)(unsigned long)lds;
    const float sl2 = exp2f(-2.0f * (float)(h + 1)) * 1.4426950408889634f;
    const bf16* ksrc = zb + (size_t)lane * ZW + ZC_KA + h * 128 + (2 * wave) * 8;
    const bf16* vsrc = zb + (size_t)(16 * ((2 * wave) & 3) + (lane >> 2)) * ZW + ZC_VA + h * 128 + (wave >> 1) * 32 + (lane & 3) * 8;
    const unsigned kdst = lds0 + (2 * wave) * 1024, vdst = lds0 + OFF_V + (2 * wave) * 1024;
#define ATT_DMA(t, slot) do { const size_t to_ = (size_t)(t) * 64 * ZW; const unsigned so_ = (unsigned)(slot) * SLOT; \
        glds16(ksrc + to_, (unsigned)__builtin_amdgcn_readfirstlane(kdst + so_)); glds16(ksrc + to_ + 8, (unsigned)__builtin_amdgcn_readfirstlane(kdst + so_ + 1024)); \
        glds16(vsrc + to_, (unsigned)__builtin_amdgcn_readfirstlane(vdst + so_)); glds16(vsrc + to_ + (size_t)16 * ZW, (unsigned)__builtin_amdgcn_readfirstlane(vdst + so_ + 1024)); } while (0)
    { const bf16* qsrc = zb + (size_t)(q0 + 32 * wave + r32) * ZW + ZC_QA + h * 128 + hi * 8;
#pragma unroll
      for (int i = 0; i < 8; ++i) glds16(qsrc + 16 * i, (unsigned)__builtin_amdgcn_readfirstlane(lds0 + OFF_Q + wave * 8192 + i * 1024)); }
    ATT_DMA(0, 0);
    const LAS unsigned char* Qw = lds + OFF_Q + wave * 8192 + r32 * 16 + hi * 512;
    LAS float* wsf = (LAS float*)(lds + OFF_WS + wave * 256);
    const int vlane = (4 * hi + ((lane & 15) >> 2)) * 64 + ((lane >> 4) & 1) * 32 + (lane & 3) * 8;
    f32x16 o1[4], o2[4];
#pragma unroll
    for (int d = 0; d < 4; ++d) { o1[d] = f32x16{}; o2[d] = f32x16{}; }
    float mh1 = 0.f, mh2 = 0.f, l1 = 0.f, l2 = 0.f;
    const int NT = 4 * (qb + 1);
    const int qrel = 32 * wave + r32;
    for (int t = 0; t < NT; ++t) {
        ATT_WAIT_BAR();
        if (t + 1 < NT) ATT_DMA(t + 1, (t + 1) & 1);
        const int jb = t - (NT - 4);
        if (jb >= 0 && 64 * jb > 32 * wave + 31) continue;
        int hi_ = hi, qrel_ = qrel; asm volatile("" : "+v"(hi_), "+v"(qrel_));
        const LAS unsigned char* Ks = lds + (t & 1) * SLOT + r32 * 16 + hi * 1024;
        const LAS unsigned char* Vs = lds + (t & 1) * SLOT + OFF_V + vlane;
#define ATT_STEP(MI, KB, MH, LL, OO) do { \
        f32x16 sa; \
        { const float base0 = sl2 * (float)(64 * t + 32 * KB + 4 * hi_) - MH; \
          _Pragma("unroll") for (int r = 0; r < 16; ++r) sa[r] = base0 + sl2 * (float)((r & 3) + 8 * (r >> 2)); \
          if (jb >= 0) { _Pragma("unroll") for (int r = 0; r < 16; ++r) { if (64 * jb + 32 * KB + crow(r, hi_) > qrel_) sa[r] = -INFINITY; } } } \
        _Pragma("unroll") for (int d0 = 0; d0 < 4; ++d0) { \
            const bf16x8 qf = *(const LAS bf16x8*)(Qw + (8 * MI + 2 * d0) * 512); \
            const bf16x8 ka = *(const LAS bf16x8*)(Ks + (8 * MI + 2 * d0) * 1024 + KB * 512); \
            sa = __builtin_amdgcn_mfma_f32_32x32x16_bf16(ka, qf, sa, 0, 0, 0); } \
        float rm; \
        { float a = fmaxf(sa[0], sa[1]); \
          _Pragma("unroll") for (int r = 2; r < 16; ++r) a = fmaxf(a, sa[r]); \
          auto rr = __builtin_amdgcn_permlane32_swap(__float_as_uint(a), __float_as_uint(a), false, false); \
          rm = fmaxf(__uint_as_float(rr[0]), __uint_as_float(rr[1])); } \
        const bool first_ = (t == 0 && KB == 0); \
        if (first_ || __any(rm > (float)THRL)) { \
            const float dl = first_ ? rm : fmaxf(rm, 0.f); \
            MH += dl; \
            _Pragma("unroll") for (int r = 0; r < 16; ++r) sa[r] -= dl; \
            if (!first_) { \
                const float f = __builtin_amdgcn_exp2f(-dl); LL *= f; \
                if (hi == 0) wsf[r32] = f; \
                LDS_WAIT(); \
                _Pragma("unroll") for (int r = 0; r < 16; ++r) { const float fr_ = wsf[crow(r, hi)]; \
                    _Pragma("unroll") for (int d = 0; d < 4; ++d) OO[d][r] *= fr_; } \
                LDS_WAIT(); \
            } } \
        u32x4 pa, pb; \
        { float s_ = 0.f; \
          _Pragma("unroll") for (int r = 0; r < 16; ++r) { sa[r] = __builtin_amdgcn_exp2f(sa[r]); s_ += sa[r]; } \
          LL += s_; \
          _Pragma("unroll") for (int i = 0; i < 4; ++i) { pa[i] = cvtpk(sa[2 * i], sa[2 * i + 1]); pb[i] = cvtpk(sa[8 + 2 * i], sa[9 + 2 * i]); } } \
        __builtin_amdgcn_sched_barrier(0); \
        _Pragma("unroll") for (int d0 = 0; d0 < 4; ++d0) { \
            const s16x4 lo0 = vtr(Vs + (d0 * 4 + 2 * KB) * 1024), hh0 = vtr(Vs + (d0 * 4 + 2 * KB) * 1024 + 512); \
            const s16x4 lo1 = vtr(Vs + (d0 * 4 + 2 * KB + 1) * 1024), hh1 = vtr(Vs + (d0 * 4 + 2 * KB + 1) * 1024 + 512); \
            OO[d0] = __builtin_amdgcn_mfma_f32_32x32x16_bf16(__builtin_bit_cast(bf16x8, pa), ((bf16x8){lo0[0], lo0[1], lo0[2], lo0[3], hh0[0], hh0[1], hh0[2], hh0[3]}), OO[d0], 0, 0, 0); \
            OO[d0] = __builtin_amdgcn_mfma_f32_32x32x16_bf16(__builtin_bit_cast(bf16x8, pb), ((bf16x8){lo1[0], lo1[1], lo1[2], lo1[3], hh1[0], hh1[1], hh1[2], hh1[3]}), OO[d0], 0, 0, 0); } \
        __builtin_amdgcn_sched_barrier(0); \
    } while (0)
        ATT_STEP(0, 0, mh1, l1, o1);
        ATT_STEP(1, 0, mh2, l2, o2);
        if (jb < 0 || 64 * jb + 32 <= 32 * wave + 31) {
            ATT_STEP(0, 1, mh1, l1, o1);
            ATT_STEP(1, 1, mh2, l2, o2);
        }
    }
    { auto rr = __builtin_amdgcn_permlane32_swap(__float_as_uint(l1), __float_as_uint(l1), false, false); l1 = __uint_as_float(rr[0]) + __uint_as_float(rr[1]); }
    { auto rr = __builtin_amdgcn_permlane32_swap(__float_as_uint(l2), __float_as_uint(l2), false, false); l2 = __uint_as_float(rr[0]) + __uint_as_float(rr[1]); }
    if (hi == 0) { wsf[r32] = 1.0f / l1; wsf[32 + r32] = lam / l2; }
    LDS_WAIT();
    float nw[4];
#pragma unroll
    for (int d = 0; d < 4; ++d) nw[d] = normw[d * 32 + r32] * post;
    ATT_WAIT_BAR();
    LAS bf16* stg = (LAS bf16*)(lds + OFF_Q + wave * 8192);
#pragma unroll
    for (int r = 0; r < 16; ++r) {
        const int orow = crow(r, hi); const float f1 = wsf[orow], f2 = wsf[32 + orow];
        float v[4], ss = 0.f;
#pragma unroll
        for (int d = 0; d < 4; ++d) { v[d] = o1[d][r] * f1 - o2[d][r] * f2; ss += v[d] * v[d]; }
#pragma unroll
        for (int o = 1; o < 32; o <<= 1) ss += __shfl_xor(ss, o);
        const float sc = 1.0f / sqrtf(ss * (1.0f / 128.0f) + LN_EPS);
#pragma unroll
        for (int d = 0; d < 4; ++d) stg[orow * 128 + d * 32 + r32] = (bf16)f2bf(v[d] * sc * nw[d]);
    }
    LDS_WAIT();
    bf16* orow0 = zb + (size_t)(q0 + 32 * wave) * ZW + ZC_QA + h * 128;
#pragma unroll
    for (int i = 0; i < 8; ++i) { const int row = i * 4 + (lane >> 4), ch = lane & 15; const u32x4 v = *(const LAS u32x4*)(stg + row * 128 + ch * 8); *(GAS u32x4*)(orow0 + (size_t)row * ZW + ch * 8) = v; }
    ATT_WAIT_BAR();
#undef ATT_DMA
#undef ATT_STEP
}
}

namespace chn {
using att::bf16x8; using att::s16x4; using att::f32x16; using att::u32x4; using att::vtr; using att::glds16; using att::cvtpk; using att::crow;
#define CHN_BAR() asm volatile("s_waitcnt lgkmcnt(0)\n\ts_barrier" ::: "memory")
#define CHN_WAIT_BAR() asm volatile("s_waitcnt vmcnt(0) lgkmcnt(0)\n\ts_barrier" ::: "memory")
template <int MIXER>
__device__ __forceinline__ void chain_unit(bf16* Z, int b, int h, int l, const Args& a, LAS unsigned char* lds) {
    PHASE_IDS();
    constexpr int DK = MIXER == 0 ? 64 : 128, NCH = DK / 64, NDC = DK / 8, NKS = DK / 16, NSD = DK / 64, NCHUNK = T / 64;
    constexpr int ZQ = MIXER == 0 ? ZC_QG : ZC_QH, ZK = MIXER == 0 ? ZC_KG : ZC_FH, ZV = MIXER == 0 ? ZC_VG : ZC_IH, ZG = MIXER == 0 ? ZC_GO : ZC_HO;
    constexpr int OV = 0, OQA = 32768, OKA = OQA + DK * 128, OQS = OKA + DK * 128, OKD = OQS + DK * 128, OS2 = OKD + DK * 128, OGT = OS2 + DK * 256, OEV = OGT + DK * 32, OSSQ = OEV + DK * 4;
    static_assert(OSSQ + 1024 <= RING_BYTES, "chain LDS map");
    const int r32 = lane & 31, hi = lane >> 5, ib = wave >> 2, dvb = wave & 3;
    bf16* zb = Z + (size_t)b * T * ZW;
    const unsigned lds0 = (unsigned)(unsigned long)lds;
    const float* normw = (MIXER == 0 ? a.in[6] : a.in[7]) + l * 128;
    float lbv[NCH], omlb[NCH], wg[MIXER == 0 ? 16 : 1], bgv = 0.f;
    if (MIXER == 0) {
        const float* Wg = a.in[2] + (size_t)l * 16 * 256 + h * 64 + lane;
#pragma unroll
        for (int r = 0; r < 16; ++r) wg[r] = Wg[r * 256];
        bgv = a.in[3][l * 256 + h * 64 + lane]; lbv[0] = 0.f; omlb[0] = 1.f;
    } else {
#pragma unroll
        for (int ch = 0; ch < NCH; ++ch) { const int c = h * 128 + NCH * lane + ch; const float x0 = a.in[8][c], x1 = a.in[8][512 + c], mx = fmaxf(x0, x1), e0 = expf(x0 - mx), e1 = expf(x1 - mx);
            lbv[ch] = (l == 0) ? 0.f : e1 / (e0 + e1); omlb[ch] = 1.0f - lbv[ch]; }
        wg[0] = 0.f;
    }
    const float nwv = normw[32 * dvb + r32];
    const bf16* vsrc = zb + (size_t)(16 * ((2 * wave) & 3) + (lane >> 2)) * ZW + ZV + h * 128 + (wave >> 1) * 32 + (lane & 3) * 8;
    const unsigned vdst = lds0 + OV + (2 * wave) * 1024;
#define CHN_DMA(c, slot) do { const size_t to_ = (size_t)(c) * 64 * ZW; const unsigned so_ = (unsigned)(slot) * 16384; \
        glds16(vsrc + to_, (unsigned)__builtin_amdgcn_readfirstlane(vdst + so_)); glds16(vsrc + to_ + (size_t)16 * ZW, (unsigned)__builtin_amdgcn_readfirstlane(vdst + so_ + 1024)); } while (0)
    unsigned pq[8], pk[8], pg[8];
#define CHN_LOAD(c) do { _Pragma("unroll") for (int tt = 0; tt < 8; ++tt) { const bf16* rp = zb + (size_t)((c) * 64 + 8 * wave + tt) * ZW; \
        if (MIXER == 0) { pq[tt] = rp[ZQ + h * 64 + lane]; pk[tt] = rp[ZK + h * 64 + lane]; pg[tt] = rp[ZC_GLR + (lane & 15)]; } \
        else { pq[tt] = *(const unsigned*)(rp + ZQ + h * 128 + 2 * lane); pk[tt] = *(const unsigned*)(rp + ZK + h * 128 + 2 * lane); pg[tt] = 0u; } } } while (0)
    CHN_LOAD(0);
    CHN_DMA(0, 0);
    f32x16 S[NSD];
#pragma unroll
    for (int n = 0; n < NSD; ++n) S[n] = f32x16{};
    const int vperm = (4 * hi + ((lane & 15) >> 2)) * 64 + ((lane >> 4) & 1) * 32 + (lane & 3) * 8;
    const int vnat = (8 * hi + ((lane & 15) >> 2)) * 64 + ((lane >> 4) & 1) * 32 + (lane & 3) * 8;
    LAS float* GT = (LAS float*)(lds + OGT);
    LAS float* EV = (LAS float*)(lds + OEV);
    LAS float* SSQ = (LAS float*)(lds + OSSQ);
    for (int c = 0; c < NCHUNK; ++c) {
        float lg[8][NCH], kk[8][NCH], qq[8][NCH];
#pragma unroll
        for (int tt = 0; tt < 8; ++tt) {
            if (MIXER == 0) {
                const float glf = bf2f((unsigned short)pg[tt]); float pre = bgv;
#pragma unroll
                for (int r = 0; r < 16; ++r) pre += __int_as_float(__builtin_amdgcn_readlane(__float_as_int(glf), r)) * wg[r];
                lg[tt][0] = -__logf(1.0f + __expf(-pre)) * (1.0f / 16.0f); kk[tt][0] = bf2f((unsigned short)pk[tt]); qq[tt][0] = bf2f((unsigned short)pq[tt]) * 0.125f;
            } else {
#pragma unroll
                for (int ch = 0; ch < NCH; ++ch) {
                    const float fh = ch == 0 ? pg8::bflo(pk[tt]) : pg8::bfhi(pk[tt]);
                    const float e_ = __expf(-fminf(fmaxf(fh, -80.f), 80.f)), sg = 1.0f / (1.0f + e_);
                    lg[tt][ch] = __logf(lbv[ch] + omlb[ch] * sg); kk[tt][ch] = omlb[ch] * e_ * sg; qq[tt][ch] = ch == 0 ? pg8::bflo(pq[tt]) : pg8::bfhi(pq[tt]);
                }
            }
        }
#pragma unroll
        for (int ch = 0; ch < NCH; ++ch) {
#pragma unroll
            for (int tt = 1; tt < 8; ++tt) lg[tt][ch] += lg[tt - 1][ch];
            GT[wave * DK + NCH * lane + ch] = lg[7][ch];
        }
        CHN_BAR();
#pragma unroll
        for (int ch = 0; ch < NCH; ++ch) {
            float pre = 0.f, ref = 0.f, last = 0.f;
#pragma unroll
            for (int w2 = 0; w2 < 8; ++w2) { const float g = GT[w2 * DK + NCH * lane + ch]; if (w2 < wave) pre += g; if (w2 < 4) ref += g; last += g; }
            const float eref = __expf(ref), elr = __expf(last - ref);
            unsigned kdp[4];
#pragma unroll
            for (int tt = 0; tt < 8; ++tt) {
                const float cum = pre + lg[tt][ch];
                const float a_ = __expf(fminf(fmaxf(cum - ref, -80.f), 80.f)), ia = __builtin_amdgcn_rcpf(a_);
                const float qa = qq[tt][ch] * a_, ka = kk[tt][ch] * ia;
                lg[tt][ch] = qa; kk[tt][ch] = ka; qq[tt][ch] = qa * eref;
                const float kd = ka * elr;
                if (tt & 1) kdp[tt >> 1] |= f2bf(kd) << 16; else kdp[tt >> 1] = f2bf(kd);
            }
            const int d = NCH * lane + ch;
            *(LAS u32x4*)(lds + OKD + wave * (DK * 16) + d * 16) = (u32x4){kdp[0], kdp[1], kdp[2], kdp[3]};
            if (wave == 0) EV[d] = __expf(last);
        }
#pragma unroll
        for (int tt = 0; tt < 8; ++tt) {
            const int tok = 8 * wave + tt;
            if (NCH == 1) { const int d = lane, off = (d >> 3) * 1024 + tok * 16 + (d & 7) * 2;
                *(LAS unsigned short*)(lds + OQA + off) = (unsigned short)f2bf(lg[tt][0]); *(LAS unsigned short*)(lds + OKA + off) = (unsigned short)f2bf(kk[tt][0]); *(LAS unsigned short*)(lds + OQS + off) = (unsigned short)f2bf(qq[tt][0]);
            } else { const int d = 2 * lane, off = (d >> 3) * 1024 + tok * 16 + (d & 7) * 2;
                *(LAS unsigned*)(lds + OQA + off) = pk2(lg[tt][0], lg[tt][NCH - 1]); *(LAS unsigned*)(lds + OKA + off) = pk2(kk[tt][0], kk[tt][NCH - 1]); *(LAS unsigned*)(lds + OQS + off) = pk2(qq[tt][0], qq[tt][NCH - 1]); }
        }
        CHN_WAIT_BAR();
        const int slot = c & 1;
        if (c + 1 < NCHUNK) { CHN_DMA(c + 1, slot ^ 1); CHN_LOAD(c + 1); }
        unsigned short gv[16];
        { const bf16* gp = zb + (size_t)(c * 64 + 32 * ib + 4 * hi) * ZW + ZG + h * 128 + 32 * dvb + r32;
#pragma unroll
          for (int r = 0; r < 16; ++r) gv[r] = gp[(size_t)((r & 3) + 8 * (r >> 2)) * ZW]; }
        const LAS unsigned char* Vs = lds + OV + slot * 16384;
        f32x16 o = f32x16{};
        if (c > 0) {
#pragma unroll
            for (int s = 0; s < NKS; ++s) {
                const bf16x8 af = *(const LAS bf16x8*)(lds + OQS + (2 * s + hi) * 1024 + (32 * ib + r32) * 16);
                const bf16x8 bf = *(const LAS bf16x8*)(lds + OS2 + dvb * (NDC * 512) + (2 * s + hi) * 512 + r32 * 16);
                o = __builtin_amdgcn_mfma_f32_32x32x16_bf16(af, bf, o, 0, 0, 0);
            }
        }
        __builtin_amdgcn_sched_barrier(0);
        for (int jb = 0; jb <= ib; ++jb) {
            f32x16 at = f32x16{};
#pragma unroll
            for (int s = 0; s < NKS; ++s) {
                const bf16x8 kf = *(const LAS bf16x8*)(lds + OKA + (2 * s + hi) * 1024 + (32 * jb + r32) * 16);
                const bf16x8 qf = *(const LAS bf16x8*)(lds + OQA + (2 * s + hi) * 1024 + (32 * ib + r32) * 16);
                at = __builtin_amdgcn_mfma_f32_32x32x16_bf16(kf, qf, at, 0, 0, 0);
            }
            if (jb == ib) {
#pragma unroll
                for (int r = 0; r < 16; ++r) if (crow(r, hi) > r32) at[r] = 0.f;
            }
            u32x4 pa, pb;
#pragma unroll
            for (int i = 0; i < 4; ++i) { pa[i] = cvtpk(at[2 * i], at[2 * i + 1]); pb[i] = cvtpk(at[8 + 2 * i], at[9 + 2 * i]); }
            const LAS unsigned char* vp = Vs + (dvb * 4 + 2 * jb) * 1024 + vperm;
            const s16x4 lo0 = vtr(vp), hh0 = vtr(vp + 512), lo1 = vtr(vp + 1024), hh1 = vtr(vp + 1024 + 512);
            o = __builtin_amdgcn_mfma_f32_32x32x16_bf16(__builtin_bit_cast(bf16x8, pa), ((bf16x8){lo0[0], lo0[1], lo0[2], lo0[3], hh0[0], hh0[1], hh0[2], hh0[3]}), o, 0, 0, 0);
            o = __builtin_amdgcn_mfma_f32_32x32x16_bf16(__builtin_bit_cast(bf16x8, pb), ((bf16x8){lo1[0], lo1[1], lo1[2], lo1[3], hh1[0], hh1[1], hh1[2], hh1[3]}), o, 0, 0, 0);
        }
        __builtin_amdgcn_sched_barrier(0);
#pragma unroll
        for (int n = 0; n < NSD; ++n) {
            const int db = NSD * ib + n;
#pragma unroll
            for (int g4 = 0; g4 < 4; ++g4) { const att::f32x4_t e4 = *(const LAS att::f32x4_t*)(EV + 32 * db + 8 * g4 + 4 * hi);
                S[n][4 * g4 + 0] *= e4[0]; S[n][4 * g4 + 1] *= e4[1]; S[n][4 * g4 + 2] *= e4[2]; S[n][4 * g4 + 3] *= e4[3]; }
#pragma unroll
            for (int s = 0; s < 4; ++s) {
                const bf16x8 af = *(const LAS bf16x8*)(lds + OKD + (2 * s + hi) * (DK * 16) + (32 * db + r32) * 16);
                const LAS unsigned char* vp = Vs + (dvb * 4 + s) * 1024 + vnat;
                const s16x4 lo = vtr(vp), hh = vtr(vp + 256);
                S[n] = __builtin_amdgcn_mfma_f32_32x32x16_bf16(af, ((bf16x8){lo[0], lo[1], lo[2], lo[3], hh[0], hh[1], hh[2], hh[3]}), S[n], 0, 0, 0);
            }
        }
#pragma unroll
        for (int r = 0; r < 16; ++r) { float ss = o[r] * o[r];
#pragma unroll
            for (int of = 1; of < 32; of <<= 1) ss += __shfl_xor(ss, of);
            if (r32 == 0) SSQ[(ib * 32 + crow(r, hi)) * 4 + dvb] = ss; }
        CHN_BAR();
#pragma unroll
        for (int r = 0; r < 16; ++r) {
            const int tok = crow(r, hi); const att::f32x4_t t4 = *(const LAS att::f32x4_t*)(SSQ + (ib * 32 + tok) * 4);
            const float sc = 1.0f / sqrtf(((t4[0] + t4[1]) + (t4[2] + t4[3])) * (1.0f / 128.0f) + LN_EPS);
            const float g = bf2f(gv[r]); const float y = o[r] * sc * nwv * (g / (1.0f + __expf(-g)));
            *(GAS unsigned short*)(zb + (size_t)(c * 64 + 32 * ib + tok) * ZW + ZV + h * 128 + 32 * dvb + r32) = (unsigned short)f2bf(y);
        }
#pragma unroll
        for (int n = 0; n < NSD; ++n) {
            const int db = NSD * ib + n;
#pragma unroll
            for (int g4 = 0; g4 < 4; ++g4) { v2u w2; w2.x = cvtpk(S[n][4 * g4 + 0], S[n][4 * g4 + 1]); w2.y = cvtpk(S[n][4 * g4 + 2], S[n][4 * g4 + 3]);
                *(LAS v2u*)(lds + OS2 + dvb * (NDC * 512) + (4 * db + g4) * 512 + r32 * 16 + 8 * hi) = w2; }
        }
    }
    CHN_WAIT_BAR();
#undef CHN_DMA
#undef CHN_LOAD
}
}

__global__ void __launch_bounds__(NWAVES * 64, 2) skel_fwd(Args args) {
    extern __shared__ __attribute__((aligned(16))) unsigned char lds[];
    Frame F;
    F.lds = (LAS unsigned char*)lds;
    F.MISC = (volatile LAS unsigned*)(F.lds + MISC_OFF);
    F.G = gridDim.x; { const int bx = blockIdx.x; F.vcu = (F.G % 8 == 0) ? (bx % 8) * (F.G / 8) + bx / 8 : bx; }
    unsigned char* ws = args.ws;
    F.ctl = (gu32*)(ws + WS_CTL);
    for (int u = threadIdx.x; u < (LDS_BYTES - LDSCTL_OFF) / 4; u += NWAVES * 64) ((LAS unsigned*)(F.lds + LDSCTL_OFF))[u] = 0u;
    __syncthreads();
    XcdBarrier bar; bar.bar = (unsigned*)(F.ctl + CW_BAR); bar.x = 0; bar.st = nullptr;
    if (MK_N_LAUNCHES == 1) bar = xcd_barrier_post((unsigned*)(F.ctl + CW_BAR), F.MISC + 8);
#define GRID_BAR() do { if (MK_N_LAUNCHES == 1) xcd_barrier(bar); } while (0)
    const int lo = args.ph_lo, hi = args.ph_hi;
#define PHON(j) (((MK_PHASE_MASK) >> (j)) & 1)
#define IN(k) (lo <= (k) && (k) < hi)
#define BOTH(k) (IN(k) && IN((k) + 1))

    bf16* const XB = (bf16*)(ws + WS_XB);
    bf16* const Z = (bf16*)(ws + WS_Z);
    bf16* const H = (bf16*)(ws + WS_Z);
    float* const R = args.out;

    if (PHON(0) && IN(0)) { p0_prologue(F, args); if (BOTH(0)) GRID_BAR(); }

    for (int l = 0; l < DEPTH; ++l) {
        const int pb = 1 + 8 * l;
        const bf16* WinT = (const bf16*)(ws + WS_WIN) + (size_t)l * NWIN * D;
        const bf16* WbT = (const bf16*)(ws + WS_WB) + (size_t)l * 3 * D * 512;
        const bf16* WoutT = (const bf16*)(ws + WS_WOUT) + (size_t)l * D * D;
        const bf16* WupT = (const bf16*)(ws + WS_WUP) + (size_t)l * FF * D;
        const bf16* WdnT = (const bf16*)(ws + WS_WDN) + (size_t)l * D * FF;

        if (PHON(1) && IN(pb + 0)) {
            pg8::Gemm g{XB, WinT, D, D, D}; pg8::StaticOrder S; S.init(M, ZW, F.G, (int)blockIdx.x);
            pg8::EpiZ E{Z, ZW, 2, 0.125f * 1.4426950408889634f};
            pg8::gemm_phase<pg8::EpiZ, pg8::StaticOrder, true>(F.lds, g, S, E);
            if (BOTH(pb + 0)) GRID_BAR();
        }
        if (PHON(2) && IN(pb + 1)) {
            if (blockIdx.x < 128) {
                const int cu = blockIdx.x, bh = cu & 63;
                if (cu < 64) chn::chain_unit<0>(Z, bh >> 2, bh & 3, l, args, F.lds);
                else chn::chain_unit<1>(Z, bh >> 2, bh & 3, l, args, F.lds);
            }
            const float lam_init = 0.8f - 0.6f * expf(-0.3f * (float)l);
            const float* lp = args.in[4] + l * 256;
            PHASE_IDS();
            const float lam = expf(wave_sum(lp[lane] * lp[64 + lane])) - expf(wave_sum(lp[128 + lane] * lp[192 + lane])) + lam_init;
            gu32* qhead = F.ctl + CW_QUEUE + 64 * l;
            for (;;) {
                __syncthreads();
                if (tid == 0) F.MISC[16] = __hip_atomic_fetch_add(qhead, 1u, RLX_AGENT);
                __syncthreads();
                const unsigned it = F.MISC[16];
                if (it >= 512u) break;
                const int qb = 7 - (int)(it >> 6), bh = (int)(it & 63u);
                att::attn_unit<8>(Z, bh >> 2, bh & 3, qb, lam, 1.0f - lam_init, args.in[5] + l * 128, F.lds);
            }
            if (BOTH(pb + 1)) GRID_BAR();
        }
        if (PHON(3) && IN(pb + 2)) {
            pg8::StaticOrder S; S.init(M, D, F.G, (int)blockIdx.x);
            for (int n = 0; n < 3; ++n) {
                { pg8::Gemm g{XB, WinT + (size_t)(ZW + n * D) * D, D, D, D};
                  pg8::EpiBf16<1> E{Z + ZC_GATE, ZW};
                  pg8::gemm_phase<pg8::EpiBf16<1>, pg8::StaticOrder, true>(F.lds, g, S, E); }
                VM_WAIT(); __syncthreads();
                { const int boff = (n == 0) ? ZC_QA : (n == 1) ? ZC_VG : ZC_IH;
                  pg8::Gemm g{Z + boff, WbT + (size_t)n * D * 512, 512, ZW, 512};
                  pg8::EpiMerge E{Z + ZC_MRG, Z + ZC_GATE, ZW, n == 0 ? 1 : 0};
                  pg8::gemm_phase<pg8::EpiMerge, pg8::StaticOrder, true>(F.lds, g, S, E); }
                VM_WAIT(); __syncthreads();
            }
            if (BOTH(pb + 2)) GRID_BAR();
        }
        if (PHON(4) && IN(pb + 3)) {
            pg8::Gemm g{Z + ZC_MRG, WoutT, D, ZW, D}; pg8::StaticOrder S; S.init(M, D, F.G, (int)blockIdx.x);
            pg8::EpiResF32 E{l == 0 ? args.in[0] : R, R, D, ALPHA};
            pg8::gemm_phase<pg8::EpiResF32, pg8::StaticOrder, true>(F.lds, g, S, E);
            if (BOTH(pb + 3)) GRID_BAR();
        }
        if (PHON(5) && IN(pb + 4)) { ln_phase(F, R, XB, args.in[11] + l * D, args.in[12] + l * D); if (BOTH(pb + 4)) GRID_BAR(); }
        if (PHON(6) && IN(pb + 5)) {
            pg8::Gemm g{XB, WupT, D, D, D}; pg8::StaticOrder S; S.init(M, FF, F.G, (int)blockIdx.x);
            pg8::EpiBf16<2> E{H, FF};
            pg8::gemm_phase<pg8::EpiBf16<2>, pg8::StaticOrder, true>(F.lds, g, S, E);
            if (BOTH(pb + 5)) GRID_BAR();
        }
        if (PHON(7) && IN(pb + 6)) {
            pg8::Gemm g{H, WdnT, FF, FF, FF}; pg8::StaticOrder S; S.init(M, D, F.G, (int)blockIdx.x);
            pg8::EpiResF32 E{R, R, D, ALPHA};
            pg8::gemm_phase<pg8::EpiResF32, pg8::StaticOrder, true>(F.lds, g, S, E);
            if (BOTH(pb + 6)) GRID_BAR();
        }
        if (PHON(8) && IN(pb + 7)) { ln_phase(F, R, XB, args.in[15] + l * D, args.in[16] + l * D); if (BOTH(pb + 7)) GRID_BAR(); }
    }
#undef IN
#undef BOTH
#undef GRID_BAR
}

extern "C" void kernel_launch(void* const* d_in, const int* in_sizes, int n_in, void* d_out, int out_size, void* d_ws, size_t ws_size, hipStream_t stream) {
    static int grid = 0;
    if (grid == 0) {
        if (n_in != 17 || in_sizes[0] != M * D || out_size != M * D || ws_size < WS_END) { fprintf(stderr, "kernel_launch: unexpected shapes / workspace (n_in %d, ws %zu); nothing launched\n", n_in, ws_size); grid = -1; return; }
        int dev = 0, cus = 0, per_cu = 0;
        if (hipGetDevice(&dev) != hipSuccess || hipDeviceGetAttribute(&cus, hipDeviceAttributeMultiprocessorCount, dev) != hipSuccess) { grid = -1; return; }
        if (hipFuncSetAttribute((const void*)skel_fwd, hipFuncAttributeMaxDynamicSharedMemorySize, LDS_BYTES) != hipSuccess) { fprintf(stderr, "kernel_launch: hipFuncSetAttribute failed\n"); grid = -1; return; }
        if (hipOccupancyMaxActiveBlocksPerMultiprocessor(&per_cu, (const void*)skel_fwd, NWAVES * 64, LDS_BYTES) != hipSuccess || per_cu < 1)
            fprintf(stderr, "kernel_launch: note: occupancy query reports %d workgroups per CU\n", per_cu);
        (void)hipGetLastError();
        grid = cus;
    }
    if (grid < 0) return;
    if (hipMemsetAsync((char*)d_ws + WS_CTL, 0, CTL_ZERO_BYTES, stream) != hipSuccess) return;
    Args a{};
    for (int i = 0; i < 17; ++i) a.in[i] = (const float*)d_in[i];
    a.out = (float*)d_out; a.ws = (unsigned char*)d_ws;
    if (MK_N_LAUNCHES == 1) {
        a.ph_lo = 0; a.ph_hi = NPHASE;
        hipLaunchKernelGGL(skel_fwd, dim3(grid), dim3(NWAVES * 64), LDS_BYTES, stream, a);
    } else {
        for (int p = 0; p < NPHASE; ++p) { a.ph_lo = p; a.ph_hi = p + 1; hipLaunchKernelGGL(skel_fwd, dim3(grid), dim3(NWAVES * 64), LDS_BYTES, stream, a); }
    }
}
```
